# Optimizing an MI355X kernel written in HIP

```python
import math
import jax, jax.numpy as jnp
from jax import lax
import numpy as np

D_MODEL = 1024
BATCH = 4
SEQ = 4096
DEPTH = 1

HEAD_DIM = 64
SC_WIDTH = D_MODEL
SC_HEADS = SC_WIDTH // HEAD_DIM
SC_WIN = 3
SSM_WIDTH = D_MODEL
SSM_HEADS = SSM_WIDTH // HEAD_DIM
SSM_GROUPS = 2
SSM_STATE = 128
SSM_CONV = 4
SSM_CHUNK = 128
SSM_GN = SSM_GROUPS * SSM_STATE
SSM_CONV_DIM = SSM_WIDTH + 2 * SSM_GN
MIX_WIDTH = SC_WIDTH + SSM_WIDTH
IN_WIDTH = 3 * SC_WIDTH + SSM_WIDTH + SSM_CONV_DIM + SSM_HEADS
IN_SPLITS = [SC_WIDTH, 2 * SC_WIDTH, 3 * SC_WIDTH, 3 * SC_WIDTH + SSM_WIDTH,
             3 * SC_WIDTH + SSM_WIDTH + SSM_CONV_DIM]
PEER_HEADS = 8
PEER_NKEYS = 128
PEER_EXPERTS = PEER_NKEYS * PEER_NKEYS
PEER_TOPK = 16
PEER_DKEY = 256
PEER_HALF = PEER_DKEY // 2
PEER_BLOCK = 128
DEEPNORM_ALPHA = (2.0 * DEPTH) ** 0.25
DEEPNORM_BETA = (8.0 * DEPTH) ** -0.25
LN_EPS = 1e-5
RMS_EPS = 1e-6

kernel_name = "hymba_conv_ssd_peer_deepnorm_adaln"


def layer_norm(x, g, b):
    xf = x.astype(jnp.float32)
    mu = jnp.mean(xf, -1, keepdims=True)
    var = jnp.mean(jnp.square(xf - mu), -1, keepdims=True)
    return ((xf - mu) * lax.rsqrt(var + LN_EPS) * g + b).astype(x.dtype)


def group_rms_norm(x, w, n_groups):
    shp = x.shape
    xf = x.astype(jnp.float32).reshape(shp[:-1] + (n_groups, shp[-1] // n_groups))
    xf = xf * lax.rsqrt(jnp.mean(jnp.square(xf), -1, keepdims=True) + RMS_EPS)
    return (xf.reshape(shp) * w).astype(x.dtype)


def causal_dwconv(x, w):
    k, ch = w.shape
    return lax.conv_general_dilated(x, w[:, None, :], window_strides=(1,), padding=[(k - 1, 0)],
                                    dimension_numbers=('NWC', 'WIO', 'NWC'), feature_group_count=ch)


def ssd_chunked(x, dt, a, b_in, c_in):
    bsz, seqlen, n_heads, hd = x.shape
    g = b_in.shape[2]
    r = n_heads // g
    L = SSM_CHUNK
    nc = seqlen // L
    xdt = (x * dt[..., None].astype(x.dtype)).reshape(bsz, nc, L, g, r, hd)
    a_dt = (dt * a).reshape(bsz, nc, L, g, r)
    a_dt = jnp.transpose(a_dt, (0, 3, 4, 1, 2))
    bc = b_in.reshape(bsz, nc, L, g, -1)
    cc = c_in.reshape(bsz, nc, L, g, -1)
    a_cum = jnp.cumsum(a_dt, -1)
    seg = a_cum[..., :, None] - a_cum[..., None, :]
    causal = jnp.tril(jnp.ones((L, L), dtype=bool))
    decay_in = jnp.where(causal, jnp.exp(jnp.where(causal, seg, 0.0)), 0.0).astype(x.dtype)
    cb = jnp.einsum('bclgn,bcsgn->bgcls', cc, bc)
    y_diag = jnp.einsum('bgcls,bgrcls,bcsgrp->bclgrp', cb, decay_in, xdt)
    decay_to_end = jnp.exp(a_cum[..., -1:] - a_cum).astype(x.dtype)
    chunk_states = jnp.einsum('bclgn,bgrcl,bclgrp->cbgrpn', bc, decay_to_end, xdt)
    chunk_decay = jnp.moveaxis(jnp.exp(a_cum[..., -1]), -1, 0).astype(x.dtype)

    def step(h, inp):
        s_c, d_c = inp
        return h * d_c[..., None, None] + s_c, h

    h0 = jnp.zeros(chunk_states.shape[1:], x.dtype)
    _, prev_states = lax.scan(step, h0, (chunk_states, chunk_decay))
    decay_from_start = jnp.exp(a_cum).astype(x.dtype)
    y_off = jnp.einsum('bclgn,cbgrpn,bgrcl->bclgrp', cc, prev_states, decay_from_start)
    return (y_diag + y_off).reshape(bsz, seqlen, n_heads, hd)


def hybrid_mixer(u, w_in, sc_conv_w, ssm_conv_w, ssm_conv_b, dt_bias, a_log, d_skip,
                 sc_norm_w, ssm_norm_w, w_out):
    bsz, seqlen, _ = u.shape
    proj = u @ w_in
    sc_b, sc_c, sc_h, z, xbc, dt = jnp.split(proj, IN_SPLITS, axis=-1)
    y_sc = sc_b * causal_dwconv(sc_c * sc_h, sc_conv_w)
    y_sc = group_rms_norm(y_sc, sc_norm_w, SC_HEADS)
    xbc = jax.nn.silu(causal_dwconv(xbc, ssm_conv_w) + ssm_conv_b)
    xs, bs, cs = jnp.split(xbc, [SSM_WIDTH, SSM_WIDTH + SSM_GN], axis=-1)
    dt = jax.nn.softplus(dt.astype(jnp.float32) + dt_bias.astype(jnp.float32))
    a = -jnp.exp(a_log.astype(jnp.float32))
    xh = xs.reshape(bsz, seqlen, SSM_HEADS, HEAD_DIM)
    y = ssd_chunked(xh, dt, a,
                    bs.reshape(bsz, seqlen, SSM_GROUPS, SSM_STATE),
                    cs.reshape(bsz, seqlen, SSM_GROUPS, SSM_STATE))
    y = (y + xh * d_skip[:, None]).reshape(bsz, seqlen, SSM_WIDTH)
    y_ssm = group_rms_norm(y * jax.nn.silu(z), ssm_norm_w, SSM_GROUPS)
    return jnp.concatenate([y_sc, y_ssm], axis=-1) @ w_out


def peer_ffn(u, w_query, sub_keys1, sub_keys2, expert_u, expert_v):
    bsz, seqlen, d = u.shape
    q = (u @ w_query).reshape(bsz, seqlen, PEER_HEADS, 2, PEER_HALF)
    s1 = jnp.einsum('bshk,hnk->bshn', q[..., 0, :], sub_keys1).astype(jnp.float32)
    s2 = jnp.einsum('bshk,hnk->bshn', q[..., 1, :], sub_keys2).astype(jnp.float32)
    v1, i1 = lax.top_k(s1, PEER_TOPK)
    v2, i2 = lax.top_k(s2, PEER_TOPK)
    cand = (v1[..., :, None] + v2[..., None, :]).reshape(bsz, seqlen, PEER_HEADS, PEER_TOPK * PEER_TOPK)
    top_s, top_ij = lax.top_k(cand, PEER_TOPK)
    e_idx = (jnp.take_along_axis(i1, top_ij // PEER_TOPK, axis=-1) * PEER_NKEYS
             + jnp.take_along_axis(i2, top_ij % PEER_TOPK, axis=-1))
    gate = jax.nn.softmax(top_s, axis=-1).astype(u.dtype)
    nb = (bsz * seqlen) // PEER_BLOCK
    ub = u.reshape(nb, PEER_BLOCK, d)
    eb = e_idx.reshape(nb, PEER_BLOCK, PEER_HEADS, PEER_TOPK)
    gb = gate.reshape(nb, PEER_BLOCK, PEER_HEADS, PEER_TOPK)

    def block(args):
        xt, et, gt = args
        h = jnp.einsum('td,thkd->thk', xt, expert_u[et])
        act = jax.nn.gelu(h, approximate=False) * gt
        return jnp.einsum('thk,thkd->td', act, expert_v[et])

    return lax.map(block, (ub, eb, gb)).reshape(bsz, seqlen, d)


def setup_inputs(seed: int = 0) -> dict:
    key = jax.random.key(seed)
    ks = jax.random.split(key, 24)
    f32 = jnp.float32
    nrm = lambda k, shp, s: jax.random.normal(k, shp, f32) * s
    dt0 = jnp.exp(jax.random.uniform(ks[9], (DEPTH, SSM_HEADS), f32, math.log(1e-3), math.log(1e-1)))
    return {
        "x": nrm(ks[0], (BATCH, SEQ, D_MODEL), 1.0),
        "c": nrm(ks[1], (BATCH, D_MODEL), 1.0),
        "w_cond": nrm(ks[2], (DEPTH, D_MODEL, 6 * D_MODEL), 0.2 * D_MODEL ** -0.5),
        "b_cond": nrm(ks[3], (DEPTH, 6 * D_MODEL), 0.02),
        "w_in": nrm(ks[4], (DEPTH, D_MODEL, IN_WIDTH), D_MODEL ** -0.5),
        "sc_conv_w": nrm(ks[5], (DEPTH, SC_WIN, SC_WIDTH), SC_WIN ** -0.5),
        "ssm_conv_w": nrm(ks[6], (DEPTH, SSM_CONV, SSM_CONV_DIM), SSM_CONV ** -0.5),
        "ssm_conv_b": nrm(ks[7], (DEPTH, SSM_CONV_DIM), 0.02),
        "dt_bias": dt0 + jnp.log(-jnp.expm1(-dt0)),
        "a_log": jnp.log(jax.random.uniform(ks[10], (DEPTH, SSM_HEADS), f32, 1.0, 16.0)),
        "d_skip": 1.0 + nrm(ks[11], (DEPTH, SSM_HEADS), 0.02),
        "sc_norm_w": 1.0 + nrm(ks[12], (DEPTH, SC_WIDTH), 0.02),
        "ssm_norm_w": 1.0 + nrm(ks[13], (DEPTH, SSM_WIDTH), 0.02),
        "w_out": nrm(ks[14], (DEPTH, MIX_WIDTH, D_MODEL), DEEPNORM_BETA * MIX_WIDTH ** -0.5),
        "ln1_g": 1.0 + nrm(ks[15], (DEPTH, D_MODEL), 0.02),
        "ln1_b": nrm(ks[16], (DEPTH, D_MODEL), 0.02),
        "w_query": nrm(ks[17], (DEPTH, D_MODEL, PEER_HEADS * PEER_DKEY), D_MODEL ** -0.5),
        "sub_keys1": nrm(ks[18], (DEPTH, PEER_HEADS, PEER_NKEYS, PEER_HALF), PEER_HALF ** -0.5),
        "sub_keys2": nrm(ks[19], (DEPTH, PEER_HEADS, PEER_NKEYS, PEER_HALF), PEER_HALF ** -0.5),
        "expert_u": nrm(ks[20], (DEPTH, PEER_EXPERTS, D_MODEL), D_MODEL ** -0.5),
        "expert_v": nrm(ks[21], (DEPTH, PEER_EXPERTS, D_MODEL), DEEPNORM_BETA),
        "ln2_g": 1.0 + nrm(ks[22], (DEPTH, D_MODEL), 0.02),
        "ln2_b": nrm(ks[23], (DEPTH, D_MODEL), 0.02),
    }


def reference(x, c, w_cond, b_cond, w_in, sc_conv_w, ssm_conv_w, ssm_conv_b, dt_bias, a_log,
              d_skip, sc_norm_w, ssm_norm_w, w_out, ln1_g, ln1_b, w_query, sub_keys1, sub_keys2,
              expert_u, expert_v, ln2_g, ln2_b):
    c_act = jax.nn.silu(c)
    for l in range(DEPTH):
        cond = (c_act @ w_cond[l] + b_cond[l])[:, None, :]
        shift1, scale1, gate1, shift2, scale2, gate2 = jnp.split(cond, 6, axis=-1)
        u1 = x * (1.0 + scale1) + shift1
        mix = hybrid_mixer(u1, w_in[l], sc_conv_w[l], ssm_conv_w[l], ssm_conv_b[l], dt_bias[l],
                           a_log[l], d_skip[l], sc_norm_w[l], ssm_norm_w[l], w_out[l])
        x = layer_norm(DEEPNORM_ALPHA * x + (1.0 + gate1) * mix, ln1_g[l], ln1_b[l])
        u2 = x * (1.0 + scale2) + shift2
        ffn = peer_ffn(u2, w_query[l], sub_keys1[l], sub_keys2[l], expert_u[l], expert_v[l])
        x = layer_norm(DEEPNORM_ALPHA * x + (1.0 + gate2) * ffn, ln2_g[l], ln2_b[l])
    return x
```

```cpp
#include <hip/hip_runtime.h>
#include <cstdio>
#include <cstdint>

#ifndef MK_N_LAUNCHES
#define MK_N_LAUNCHES 1
#endif

namespace pg8 {
#define PG8_LAS __attribute__((address_space(3)))
typedef unsigned short bf16_t;
typedef short bf16x8 __attribute__((ext_vector_type(8)));
typedef float f32x4 __attribute__((ext_vector_type(4)));
typedef unsigned u32x4 __attribute__((ext_vector_type(4)));
constexpr int BM = 256, BK = 64, HALF = 128, HTB = HALF * BK * 2  , STAGE_BYTES = 8 * HTB, NXCD = 8, WGM = 8;

__host__ __device__ __forceinline__ int lds_byte(int r, int c) { const int st = (r >> 4) * 2 + (c >> 5), rr = r & 15, cc = c & 31, ob = rr * 64 + cc * 2; return st * 1024 + (ob ^ (((ob >> 9) & 1) << 5)); }
__host__ __device__ __forceinline__ void stage_rc(int b, int& R, int& C) { const int st = b / 1024, sb = b % 1024, swz = sb ^ (((sb >> 9) & 1) << 5); R = (st >> 1) * 16 + swz / 64; C = (st & 1) * 32 + (swz % 64) / 2; }
__host__ __device__ __forceinline__ int perm32(int rho) { const int n = rho >> 4, i = rho & 15; return 8 * (i >> 2) + 4 * n + (i & 3); }

struct Unit { int pm, pn; };
struct Gemm { const bf16_t* A; const bf16_t* Bt; int M, N, K, lda, ldb, ksplit, kjump; };

struct StaticOrder {
    int nM, nN, nwg, G, c;
    __host__ __device__ void init(int M, int N, int G_, int c_) { nM = M / BM; nN = N / BM; nwg = nM * nN; G = G_; c = c_; }
    __host__ __device__ bool next(int i, Unit& u) const {
        const long L = (long)i * G + c; if (L >= nwg) return false;
        int wgid = (int)L; { const int q = nwg / NXCD, r = nwg % NXCD, xcd = wgid % NXCD, off = wgid / NXCD; wgid = (xcd < r ? xcd * (q + 1) : r * (q + 1) + (xcd - r) * q) + off; }
        const int nig = WGM * nN, gid = wgid / nig, fm = gid * WGM, gsz = (nM - fm) < WGM ? (nM - fm) : WGM;
        u.pm = fm + ((wgid % nig) % gsz); u.pn = (wgid % nig) / gsz; return true;
    }
    __device__ __forceinline__ void a_ready(const Unit&) const {}
    __device__ __forceinline__ void done(const Unit&) const {}
};

__device__ __forceinline__ unsigned cvt_pk_bf16(float lo, float hi) { unsigned r; asm volatile("v_cvt_pk_bf16_f32 %0, %1, %2" : "=v"(r) : "v"(lo), "v"(hi)); return r; }

struct EpiBf16 {
    static constexpr bool PERM = true;
    bf16_t* O; int ldc;
    __device__ __forceinline__ void operator()(const f32x4 (&acc)[2][2][4][2], const Unit& u, int wr, int wc, int fr, int fq) const {
        const int row0 = u.pm * BM + wr * 64 + fr; const int col0 = u.pn * BM + wc * 32 + 8 * fq;
#pragma unroll
        for (int ai = 0; ai < 2; ++ai)
#pragma unroll
            for (int m = 0; m < 4; ++m) { bf16_t* rowp = O + (size_t)(row0 + ai * HALF + m * 16) * ldc + col0;
#pragma unroll
                for (int bj = 0; bj < 2; ++bj) { const f32x4 v0 = acc[ai][bj][m][0], v1 = acc[ai][bj][m][1];
                    u32x4 w; w.x = cvt_pk_bf16(v0[0], v0[1]); w.y = cvt_pk_bf16(v0[2], v0[3]); w.z = cvt_pk_bf16(v1[0], v1[1]); w.w = cvt_pk_bf16(v1[2], v1[3]);
                    *(u32x4*)(rowp + bj * HALF) = w; } }
    }
};
struct EpiScores {
    static constexpr bool PERM = true;
    bf16_t* O;
    __device__ __forceinline__ void operator()(const f32x4 (&acc)[2][2][4][2], const Unit& u, int wr, int wc, int fr, int fq) const {
        const int kc = 4 * wc + fq;
#pragma unroll
        for (int ai = 0; ai < 2; ++ai)
#pragma unroll
            for (int m = 0; m < 4; ++m) { const int r = u.pm * BM + ai * HALF + wr * 64 + m * 16 + fr; const int tb = r >> 6, tok = r & 63;
#pragma unroll
                for (int bj = 0; bj < 2; ++bj) { const f32x4 v0 = acc[ai][bj][m][0], v1 = acc[ai][bj][m][1]; const int hh = 2 * u.pn + bj;
                    u32x4 w; w.x = cvt_pk_bf16(v0[0], v0[1]); w.y = cvt_pk_bf16(v0[2], v0[3]); w.z = cvt_pk_bf16(v1[0], v1[1]); w.w = cvt_pk_bf16(v1[2], v1[3]);
                    *(u32x4*)(O + ((((size_t)tb * 16 + hh) * 16 + kc) * 64 + tok) * 8) = w; } }
    }
};
struct EpiPre {
    static constexpr bool PERM = false;
    const float* x; const float* gate; float* out; float alpha;
    __device__ __forceinline__ void operator()(const f32x4 (&acc)[2][2][4][2], const Unit& u, int wr, int wc, int fr, int fq) const {
        const int row0 = u.pm * BM + wr * 64 + fr, col0 = u.pn * BM + wc * 32 + 4 * fq; const int b = (u.pm * BM) >> 12;
        f32x4 gv[2][2];
#pragma unroll
        for (int bj = 0; bj < 2; ++bj)
#pragma unroll
            for (int n = 0; n < 2; ++n) gv[bj][n] = *(const f32x4*)(gate + b * 6144 + col0 + bj * HALF + n * 16) + 1.0f;
#pragma unroll
        for (int ai = 0; ai < 2; ++ai)
#pragma unroll
            for (int m = 0; m < 4; ++m) { const size_t off = (size_t)(row0 + ai * HALF + m * 16) * 1024 + col0;
#pragma unroll
                for (int bj = 0; bj < 2; ++bj)
#pragma unroll
                    for (int n = 0; n < 2; ++n) { const f32x4 xv = *(const f32x4*)(x + off + bj * HALF + n * 16);
                        *(f32x4*)(out + off + bj * HALF + n * 16) = xv * alpha + gv[bj][n] * acc[ai][bj][m][n]; }
                asm volatile("" ::: "memory"); }
    }
};

template <class Epi, class Sched, bool ALIGN_EPI = true>
__device__ __forceinline__ void gemm_phase(PG8_LAS unsigned char* lds, const Gemm g, const Sched& S, const Epi& E) {
    const int tid = threadIdx.x, wid = __builtin_amdgcn_readfirstlane(tid >> 6), lane = tid & 63, wr = wid >> 2, wc = wid & 3, fr = lane & 15, fq = lane >> 4;
    const int K = g.K, nt = K / BK;
    unsigned voffA[2], voffB[2];
#pragma unroll
    for (int i = 0; i < 2; ++i) { int R, C; stage_rc(tid * 16 + i * 8192, R, C); const int Rb = Epi::PERM ? ((R & ~31) + perm32(R & 31)) : R;
        voffA[i] = (unsigned)(R * g.lda + C) * 2u; voffB[i] = (unsigned)(Rb * g.ldb + C) * 2u; }
    const size_t kstep = (size_t)(BK * 2);
    const size_t hstepA = (size_t)HALF * g.lda * 2, hstepB = (size_t)HALF * g.ldb * 2;
    const size_t tstepA = 2 * hstepA, tstepB = 2 * hstepB;
    const unsigned ldsw = (unsigned)wid * 1024u;
    const int aoff = lds_byte(wr * 64 + fr, fq * 8), boff = lds_byte(wc * 32 + fr, fq * 8);
#define PG8_SA(b, h) (((b) * 2 + (h)) * HTB)
#define PG8_SB(b, h) ((4 + (b) * 2 + (h)) * HTB)
#define PG8_STAGE(bufoff, gbase, voff) do { _Pragma("unroll") for (int _i = 0; _i < 2; ++_i) \
        __builtin_amdgcn_global_load_lds((const unsigned*)((const char*)(gbase) + (voff)[_i]), (PG8_LAS unsigned*)(lds + (bufoff) + ldsw + _i * 8192), 16, 0, 0); } while (0)
#define PG8_LDA(dst, b, h) do { _Pragma("unroll") for (int m = 0; m < 4; ++m) _Pragma("unroll") for (int k = 0; k < 2; ++k) dst[m][k] = *(const PG8_LAS bf16x8*)(lds + PG8_SA(b, h) + aoff + m * 2048 + k * 1024); } while (0)
#define PG8_LDB(dst, b, h) do { _Pragma("unroll") for (int n = 0; n < 2; ++n) _Pragma("unroll") for (int k = 0; k < 2; ++k) dst[n][k] = *(const PG8_LAS bf16x8*)(lds + PG8_SB(b, h) + boff + n * 2048 + k * 1024); } while (0)
#define PG8_MMA(ai, bj, At, Bt) do { __builtin_amdgcn_s_setprio(1); _Pragma("unroll") for (int m = 0; m < 4; ++m) _Pragma("unroll") for (int n = 0; n < 2; ++n) _Pragma("unroll") for (int k = 0; k < 2; ++k) \
        acc[ai][bj][m][n] = __builtin_amdgcn_mfma_f32_16x16x32_bf16(Bt[n][k], At[m][k], acc[ai][bj][m][n], 0, 0, 0); __builtin_amdgcn_s_setprio(0); } while (0)
#define PG8_WAIT_V(n) asm volatile("s_waitcnt vmcnt(" #n ")" ::: "memory")
#define PG8_WAIT_L(n) asm volatile("s_waitcnt lgkmcnt(" #n ")" ::: "memory")
#define PG8_BAR __builtin_amdgcn_s_barrier()
#define PG8_SCHED __builtin_amdgcn_sched_barrier(0)
#define PG8_AT(base, t) ((base) + (size_t)(t) * kstep + ((t) >= g.ksplit ? (size_t)g.kjump : (size_t)0))
    Unit cur, nxt; int ui = 0;
    if (!S.next(0, cur)) return;
    f32x4 acc[2][2][4][2];
#pragma unroll
    for (int a = 0; a < 2; ++a)
#pragma unroll
        for (int b = 0; b < 2; ++b)
#pragma unroll
            for (int m = 0; m < 4; ++m)
#pragma unroll
                for (int n = 0; n < 2; ++n) acc[a][b][m][n] = (f32x4){0.f, 0.f, 0.f, 0.f};
    bf16x8 At[4][2], B0[2][2], B1[2][2];
    const char* cA = (const char*)g.A + (size_t)cur.pm * tstepA; const char* cB = (const char*)g.Bt + (size_t)cur.pn * tstepB;
    S.a_ready(cur);
    PG8_STAGE(PG8_SB(0, 0), cB, voffB); PG8_STAGE(PG8_SB(0, 1), cB + hstepB, voffB); PG8_STAGE(PG8_SA(0, 0), cA, voffA); PG8_STAGE(PG8_SA(0, 1), cA + hstepA, voffA);
    if (wr == 1) PG8_BAR;
    PG8_WAIT_V(2); PG8_BAR;
    PG8_STAGE(PG8_SB(1, 0), cB + kstep, voffB); PG8_STAGE(PG8_SA(1, 0), cA + kstep, voffA); PG8_STAGE(PG8_SB(1, 1), cB + hstepB + kstep, voffB);
    PG8_WAIT_V(6); PG8_BAR;
    for (;;) {
        const bool has_next = S.next(ui + 1, nxt);
        const char* nA = has_next ? (const char*)g.A + (size_t)nxt.pm * tstepA : cA; const char* nB = has_next ? (const char*)g.Bt + (size_t)nxt.pn * tstepB : cB;
        for (int t = 0; t < nt; t += 2) {
            const bool last = (t == nt - 2);
            const char* a1 = PG8_AT(cA, t + 1);
            const char* a2 = last ? nA : PG8_AT(cA, t + 2); const char* b2 = last ? nB : cB + (size_t)(t + 2) * kstep;
            const char* a3 = a2 + kstep; const char* b3 = b2 + kstep;
            if (last && has_next) S.a_ready(nxt);
            PG8_LDB(B0, 0, 0); PG8_LDB(B1, 0, 1); PG8_SCHED; PG8_LDA(At, 0, 0); PG8_STAGE(PG8_SA(1, 1), a1 + hstepA, voffA);
            PG8_WAIT_V(8); PG8_WAIT_L(0); PG8_BAR; PG8_MMA(0, 0, At, B0); PG8_MMA(0, 1, At, B1); PG8_BAR; PG8_SCHED;
            PG8_LDA(At, 0, 1); PG8_STAGE(PG8_SB(0, 0), b2, voffB); PG8_STAGE(PG8_SB(0, 1), b2 + hstepB, voffB); PG8_STAGE(PG8_SA(0, 0), a2, voffA);
            PG8_WAIT_V(8); PG8_WAIT_L(0); PG8_BAR; PG8_MMA(1, 0, At, B0); PG8_MMA(1, 1, At, B1); PG8_BAR; PG8_SCHED;
            PG8_LDB(B0, 1, 0); PG8_LDB(B1, 1, 1); PG8_SCHED; PG8_LDA(At, 1, 0); PG8_STAGE(PG8_SA(0, 1), a2 + hstepA, voffA);
            PG8_WAIT_V(8); PG8_WAIT_L(0); PG8_BAR; PG8_MMA(0, 0, At, B0); PG8_MMA(0, 1, At, B1); PG8_BAR; PG8_SCHED;
            PG8_LDA(At, 1, 1); PG8_STAGE(PG8_SB(1, 0), b3, voffB); PG8_STAGE(PG8_SB(1, 1), b3 + hstepB, voffB); PG8_STAGE(PG8_SA(1, 0), a3, voffA);
            PG8_WAIT_V(8); PG8_WAIT_L(0); PG8_BAR; PG8_MMA(1, 0, At, B0); PG8_MMA(1, 1, At, B1); PG8_BAR; PG8_SCHED;
        }
        if constexpr (ALIGN_EPI) { if (wr == 0) PG8_BAR; }
        E(acc, cur, wr, wc, fr, fq); S.done(cur);
        if (!has_next) break;
#pragma unroll
        for (int a = 0; a < 2; ++a)
#pragma unroll
            for (int b = 0; b < 2; ++b)
#pragma unroll
                for (int m = 0; m < 4; ++m)
#pragma unroll
                    for (int n = 0; n < 2; ++n) acc[a][b][m][n] = (f32x4){0.f, 0.f, 0.f, 0.f};
        cur = nxt; cA = nA; cB = nB; ++ui;
        if constexpr (ALIGN_EPI) { if (wr == 1) PG8_BAR; }
    }
    PG8_WAIT_V(0);
    if constexpr (!ALIGN_EPI) { if (wr == 0) PG8_BAR; }
    PG8_BAR;
#undef PG8_SA
#undef PG8_SB
#undef PG8_STAGE
#undef PG8_LDA
#undef PG8_LDB
#undef PG8_MMA
#undef PG8_WAIT_V
#undef PG8_WAIT_L
#undef PG8_BAR
#undef PG8_SCHED
#undef PG8_AT
}
}

constexpr int NWAVES = 8, NT = 512;
constexpr int T = 16384, D = 1024, SEQ = 4096, NB = 4;
constexpr int INW = 5648, N1 = 5632;
constexpr int C_SCB = 0, C_SCC = 1024, C_SCH = 2048, C_Z = 3072, C_X = 4096, C_B = 5120, C_C = 5376, C_DT = 5632;
constexpr int NCH = 32, LCH = 128;
constexpr float ALPHA = 1.189207115f;
constexpr float LN_EPS = 1e-5f, RMS_EPS = 1e-6f;

constexpr size_t MiB = 1024 * 1024;
constexpr size_t WS_CTL = 0, CTL_ZERO_BYTES = 65536;
constexpr size_t WS_COND = 65536;
constexpr size_t WS_WOUT = 1 * MiB;
constexpr size_t WS_WQ = 5 * MiB;
constexpr size_t WS_WIN = 9 * MiB;
constexpr size_t WS_DT = 20 * MiB;
constexpr size_t WS_ACUM = 21 * MiB;
constexpr size_t WS_PROJ = 24 * MiB;
constexpr size_t WS_CN = 200 * MiB;
constexpr size_t WS_CB = 208 * MiB;
constexpr size_t WS_XT = 216 * MiB;
constexpr size_t WS_X1 = 24 * MiB;
constexpr size_t WS_U2 = 88 * MiB;
constexpr size_t WS_SC = 120 * MiB;
constexpr size_t WS_EU = 184 * MiB;
constexpr size_t WS_EV = 216 * MiB;
constexpr size_t WS_END = 248 * MiB;

constexpr int LDS_BYTES = 147456;
constexpr int LDS_MISC = 143360;

#define GAS __attribute__((address_space(1)))
#define LAS __attribute__((address_space(3)))
typedef unsigned short bf16;
typedef unsigned v4u __attribute__((ext_vector_type(4)));
typedef unsigned v2u __attribute__((ext_vector_type(2)));
typedef float f32x4 __attribute__((ext_vector_type(4)));
typedef short bf16x8 __attribute__((ext_vector_type(8)));
typedef __bf16 bf16x2_t __attribute__((ext_vector_type(2)));
#define LDS_WAIT() asm volatile("s_waitcnt lgkmcnt(0)" ::: "memory")
__device__ __forceinline__ unsigned f2bf(float f) { unsigned u = __builtin_bit_cast(unsigned, f); return (u + 0x7fffu + ((u >> 16) & 1u)) >> 16; }
__device__ __forceinline__ unsigned pk2(float lo, float hi) { return f2bf(lo) | (f2bf(hi) << 16); }
__device__ __forceinline__ float bflo(unsigned u) { return __builtin_bit_cast(float, u << 16); }
__device__ __forceinline__ float bfhi(unsigned u) { return __builtin_bit_cast(float, u & 0xffff0000u); }
__device__ __forceinline__ float bf1(bf16 b) { return __builtin_bit_cast(float, (unsigned)b << 16); }
__device__ __forceinline__ float wave_sum(float v) {
#pragma unroll
    for (int o = 1; o < 64; o <<= 1) v += __shfl_xor(v, o);
    return v;
}
__device__ __forceinline__ float silu_f(float v) { return v / (1.0f + __expf(-v)); }
__device__ __forceinline__ float dot2_bf16(unsigned w, unsigned x, float acc) { return __builtin_amdgcn_fdot2_f32_bf16(__builtin_bit_cast(bf16x2_t, w), __builtin_bit_cast(bf16x2_t, x), acc, false); }
__device__ __forceinline__ f32x4 mfma16(bf16x8 a, bf16x8 b, f32x4 c) { return __builtin_amdgcn_mfma_f32_16x16x32_bf16(a, b, c, 0, 0, 0); }

#define XB_TMO      128
#define XB_XCNT(j)  (256  + 64 * (j))
#define XB_XSUB(j)  (1280 + 64 * (j))
#define XB_XGEN(j)  (2304 + 64 * (j))
#define XB_TOP      3328
#define XB_TOPGEN   3392
#define XCD_BAR_WORDS 3456
#define XB_SPIN_CAP (1u << 18)
__device__ __forceinline__ unsigned xb_ld(unsigned* p)              { return __hip_atomic_load(p, __ATOMIC_RELAXED, __HIP_MEMORY_SCOPE_AGENT); }
__device__ __forceinline__ unsigned xb_add(unsigned* p, unsigned v) { return __hip_atomic_fetch_add(p, v, __ATOMIC_RELAXED, __HIP_MEMORY_SCOPE_AGENT); }
__device__ __forceinline__ unsigned xb_xcc_id() { return (unsigned)__builtin_amdgcn_s_getreg((3 << 11) | 20) & 0xFu; }
#define XB_SPIN(cond, bar) do { unsigned _sp = 0; while (cond) { __builtin_amdgcn_s_sleep(1); \
    if ((++_sp & 255u) == 0u) { if (xb_ld(&(bar)[XB_TMO])) break; if (_sp > XB_SPIN_CAP) { atomicAdd(&(bar)[XB_TMO], 1u); break; } } } } while (0)
struct XcdBarrier { unsigned* bar; unsigned x; volatile LAS unsigned* st; };
__device__ __forceinline__ XcdBarrier xcd_barrier_post(unsigned* bar, volatile LAS unsigned* st) {
    XcdBarrier b; b.bar = bar; b.x = xb_xcc_id(); b.st = st;
    if (threadIdx.x == 0) (void)xb_add(&bar[XB_XCNT(b.x)], 1u);
    return b;
}
__device__ __forceinline__ void xcd_barrier_complete(unsigned* bar, unsigned x, unsigned& nloc, unsigned& nx) {
    const unsigned G = gridDim.x * gridDim.y * gridDim.z;
    unsigned sum, cnt, mine, sp = 0u;
    for (;;) {
        sum = 0u; cnt = 0u; mine = 0u;
#pragma unroll
        for (unsigned j = 0; j < 16; ++j) { const unsigned c = xb_ld(&bar[XB_XCNT(j)]); sum += c; cnt += (c > 0u) ? 1u : 0u; mine = (j == x) ? c : mine; }
        if (sum == G) break;
        __builtin_amdgcn_s_sleep(1);
        if ((++sp & 255u) == 0u) { if (xb_ld(&bar[XB_TMO])) break; if (sp > XB_SPIN_CAP) { atomicAdd(&bar[XB_TMO], 1u); break; } }
    }
    nloc = mine > 0u ? mine : 1u; nx = cnt > 0u ? cnt : 1u;
}
__device__ __forceinline__ void xcd_barrier(const XcdBarrier& b) {
    asm volatile("s_waitcnt vmcnt(0)" ::: "memory");
    __syncthreads();
    if (threadIdx.x == 0) {
        unsigned* bar = b.bar;
        __builtin_amdgcn_s_waitcnt(0);
        unsigned nloc = b.st[0], nx = b.st[1];
        if (nloc == 0u) { xcd_barrier_complete(bar, b.x, nloc, nx); b.st[0] = nloc; b.st[1] = nx; }
        const unsigned old = xb_add(&bar[XB_XSUB(b.x)], 1u);
        const unsigned gen = old / nloc;
        if (old + 1u == (gen + 1u) * nloc) {
            __builtin_amdgcn_fence(__ATOMIC_RELEASE, "agent");
            asm volatile("s_waitcnt vmcnt(0)" ::: "memory");
            const unsigned og = xb_add(&bar[XB_TOP], 1u);
            const unsigned tg = og / nx;
            if (og + 1u == (tg + 1u) * nx) xb_add(&bar[XB_TOPGEN], 1u);
            else XB_SPIN(xb_ld(&bar[XB_TOPGEN]) == tg, bar);
            __builtin_amdgcn_fence(__ATOMIC_ACQUIRE, "agent");
            xb_add(&bar[XB_XGEN(b.x)], 1u);
            asm volatile("s_waitcnt vmcnt(0)" ::: "memory");
        } else {
            XB_SPIN(xb_ld(&bar[XB_XGEN(b.x)]) == gen, bar);
            __builtin_amdgcn_fence(__ATOMIC_ACQUIRE, "agent");
            asm volatile("s_waitcnt vmcnt(0)" ::: "memory");
        }
    }
    __syncthreads();
}

struct Frame {
    LAS unsigned char* lds;
    int tid, lane, wave, G, bid;
    const float *x, *c, *w_cond, *b_cond, *w_in, *sc_conv_w, *ssm_conv_w, *ssm_conv_b, *dt_bias, *a_log, *d_skip, *sc_norm_w, *ssm_norm_w, *w_out, *ln1_g, *ln1_b,
                *w_query, *sub_keys1, *sub_keys2, *expert_u, *expert_v, *ln2_g, *ln2_b;
    float* out; unsigned char* ws;
};

#define WSP(T_, off) ((T_*)(F.ws + (off)))

__device__ __forceinline__ void p0_transpose_item(const float* W, int ldw, int K, int Nn, bf16* WT, LAS float* scr, int item, int lane) {
    const int nblk = Nn / 32, kb = item / nblk, nb = item % nblk, k0 = 64 * kb, n0 = 32 * nb;
#pragma unroll 8
    for (int i = 0; i < 32; ++i) { const int kk = 2 * i + (lane >> 5); scr[kk * 33 + (lane & 31)] = W[(size_t)(k0 + kk) * ldw + n0 + (lane & 31)]; }
    LDS_WAIT(); asm volatile("" ::: "memory");
    const int c = lane & 7;
#pragma unroll
    for (int j = 0; j < 4; ++j) { const int n = (lane >> 3) + 8 * j; const LAS float* s = scr + (8 * c) * 33 + n;
        v4u o; o.x = pk2(s[0 * 33], s[1 * 33]); o.y = pk2(s[2 * 33], s[3 * 33]); o.z = pk2(s[4 * 33], s[5 * 33]); o.w = pk2(s[6 * 33], s[7 * 33]);
        *(v4u*)(WT + (size_t)(n0 + n) * K + k0 + 8 * c) = o; }
    LDS_WAIT(); asm volatile("" ::: "memory");
}
__device__ __forceinline__ void p0_wq(Frame& F, int task) {
    const int hh = task >> 4, d0 = 64 * (task & 15), h = hh >> 1, half = hh & 1, tid = F.tid;
    LAS float* keys = (LAS float*)F.lds;
    LAS float* wq = keys + 128 * 128;
    const float* kp = (half ? F.sub_keys2 : F.sub_keys1) + (size_t)h * 128 * 128;
    for (int i = tid; i < 4096; i += NT) ((LAS f32x4*)keys)[i] = ((const f32x4*)kp)[i];
    for (int i = tid; i < 64 * 32; i += NT) { const int r = i >> 5, c4 = i & 31; *(LAS f32x4*)(wq + r * 132 + 4 * c4) = *(const f32x4*)(F.w_query + (size_t)(d0 + r) * 2048 + hh * 128 + 4 * c4); }
    __syncthreads();
    const int d = tid & 63, kg = tid >> 6;
    float acc[16];
#pragma unroll
    for (int k = 0; k < 16; ++k) acc[k] = 0.f;
    for (int j4 = 0; j4 < 32; ++j4) { const f32x4 w = *(LAS f32x4*)(wq + d * 132 + 4 * j4);
#pragma unroll
        for (int k = 0; k < 16; ++k) { const f32x4 kv = *(LAS f32x4*)(keys + (16 * kg + k) * 128 + 4 * j4); acc[k] += (kv.x * w.x + kv.y * w.y) + (kv.z * w.z + kv.w * w.w); } }
    bf16* WQ = WSP(bf16, WS_WQ);
#pragma unroll
    for (int k = 0; k < 16; ++k) WQ[(size_t)(hh * 128 + 16 * kg + k) * 1024 + d0 + d] = (bf16)f2bf(acc[k]);
    __syncthreads();
}
__device__ __forceinline__ void p0_cond(Frame& F, int task) {
    const int tid = F.tid;
    LAS float* sc = (LAS float*)F.lds;
    LAS float* red = sc + 4096;
    for (int i = tid; i < 4096; i += NT) sc[i] = silu_f(F.c[i]);
    __syncthreads();
    const int l8 = tid & 7, rs = tid >> 3;
    const float* wp = F.w_cond + (size_t)rs * 6144 + 32 * task + 4 * l8;
    f32x4 w[16];
#pragma unroll
    for (int i = 0; i < 16; ++i) w[i] = *(const f32x4*)(wp + (size_t)i * 64 * 6144);
    f32x4 acc[4];
#pragma unroll
    for (int b = 0; b < 4; ++b) acc[b] = (f32x4){0.f, 0.f, 0.f, 0.f};
#pragma unroll
    for (int i = 0; i < 16; ++i)
#pragma unroll
        for (int b = 0; b < 4; ++b) acc[b] += w[i] * sc[b * 1024 + 64 * i + rs];
#pragma unroll
    for (int b = 0; b < 4; ++b)
#pragma unroll
        for (int e = 0; e < 4; ++e) { float v = acc[b][e]; v += __shfl_xor(v, 8); v += __shfl_xor(v, 16); v += __shfl_xor(v, 32); if ((F.lane >> 3) == 0) red[(F.wave * 8 + l8) * 16 + b * 4 + e] = v; }
    __syncthreads();
    if (tid < 128) { const int b = tid >> 5, col = tid & 31, q8 = col >> 2, e = col & 3; float s = 0.f;
#pragma unroll
        for (int wv = 0; wv < 8; ++wv) s += red[(wv * 8 + q8) * 16 + b * 4 + e];
        WSP(float, WS_COND)[b * 6144 + 32 * task + col] = s + F.b_cond[32 * task + col]; }
    __syncthreads();
}
__device__ __forceinline__ void p0_prologue(Frame& F) {
    for (int task = F.bid; task < 256; task += F.G) p0_wq(F, task);
    for (int task = F.bid; task < 192; task += F.G) p0_cond(F, task);
    LAS float* scr = (LAS float*)(F.lds + F.wave * 16384);
    const int gw = F.bid * NWAVES + F.wave, NGW = F.G * NWAVES;
    constexpr int I_IN = (D / 64) * (N1 / 32), I_OUT = (2048 / 64) * (1024 / 32);
    for (int it = gw; it < I_IN + I_OUT; it += NGW) {
        if (it < I_IN) p0_transpose_item(F.w_in, INW, D, N1, WSP(bf16, WS_WIN), scr, it, F.lane);
        else p0_transpose_item(F.w_out, 1024, 2048, 1024, WSP(bf16, WS_WOUT), scr, it - I_IN, F.lane);
    }
}

__device__ __forceinline__ void p1_modulate(Frame& F, bf16* U1) {
    LAS float* wdt = (LAS float*)F.lds;
    for (int i = F.tid; i < 16384; i += NT) { const int d = i >> 4, h = i & 15; wdt[h * 1024 + d] = F.w_in[(size_t)d * INW + C_DT + h]; }
    __syncthreads();
    const int gw = F.bid * NWAVES + F.wave, NGW = F.G * NWAVES, lane = F.lane;
    const float* COND = WSP(float, WS_COND); float* DT = WSP(float, WS_DT);
    for (int m = gw; m < T; m += NGW) {
        const int b = m >> 12; const float* cd = COND + b * 6144;
        const f32x4* xr = (const f32x4*)(F.x + (size_t)m * D) + lane;
        float part[16];
#pragma unroll
        for (int h = 0; h < 16; ++h) part[h] = 0.f;
#pragma unroll 1
        for (int j = 0; j < 4; ++j) { const int col = 4 * lane + 256 * j; const f32x4 v = xr[64 * j], sh = *(const f32x4*)(cd + col), scl = *(const f32x4*)(cd + 1024 + col);
            const f32x4 u = v * (scl + 1.0f) + sh;
            v2u o; o.x = pk2(u.x, u.y); o.y = pk2(u.z, u.w); *(v2u*)(U1 + (size_t)m * D + col) = o;
#pragma unroll
            for (int h = 0; h < 16; ++h) { const f32x4 w = *(LAS f32x4*)(wdt + h * 1024 + col); part[h] += (u.x * w.x + u.y * w.y) + (u.z * w.z + u.w * w.w); } }
        float mine = 0.f;
#pragma unroll
        for (int h = 0; h < 16; ++h) { const float s = wave_sum(part[h]); mine = (lane == h) ? s : mine; }
        if (lane < 16) { const float v = mine + F.dt_bias[lane]; DT[(size_t)m * 16 + lane] = v > 20.f ? v : log1pf(__expf(v)); }
    }
}

constexpr int RS = 272;
__device__ __forceinline__ void p3_unit(Frame& F, int unit, bf16* ST) {
    const int g = unit & 1, bc = unit >> 1, b = bc >> 5, c = bc & 31, t0 = b * SEQ + c * LCH, tid = F.tid, lane = F.lane, wave = F.wave;
    const int r = lane & 15, q = lane >> 4;
    LAS unsigned char* BT = F.lds;
    LAS unsigned char* R1 = F.lds + 34816;
    LAS unsigned char* Bnat = R1; LAS unsigned char* Cnat = R1 + 34816; LAS unsigned char* xwT = R1;
    LAS float* acum_s = (LAS float*)(F.lds + 104448);
    LAS float* wts = acum_s + 1024;
    const bf16* PROJ = WSP(bf16, WS_PROJ); const float* DT = WSP(const float, WS_DT); float* ACUM = WSP(float, WS_ACUM);
    {
        const int h = 8 * g + wave; const float a = -__expf(F.a_log[h]);
        const float d0 = DT[(size_t)(t0 + 2 * lane) * 16 + h], d1 = DT[(size_t)(t0 + 2 * lane + 1) * 16 + h];
        const float v0 = a * d0, v1 = a * d1; float s = v0 + v1;
#pragma unroll
        for (int o = 1; o < 64; o <<= 1) { const float t = __shfl_up(s, o); if (lane >= o) s += t; }
        float ex = __shfl_up(s, 1); if (lane == 0) ex = 0.f;
        const float c0 = ex + v0, c1 = c0 + v1, end = __shfl(s, 63);
        acum_s[wave * 128 + 2 * lane] = c0; acum_s[wave * 128 + 2 * lane + 1] = c1;
        wts[wave * 128 + 2 * lane] = d0 * __expf(end - c0); wts[wave * 128 + 2 * lane + 1] = d1 * __expf(end - c1);
        ACUM[(size_t)(t0 + 2 * lane) * 16 + h] = c0; ACUM[(size_t)(t0 + 2 * lane + 1) * 16 + h] = c1;
    }
    {
        const int ch = tid & 255, lh = tid >> 8, isC = ch >> 7, n = ch & 127;
        const int col = C_B + isC * 256 + 128 * g + n, cw = 1024 + isC * 256 + 128 * g + n;
        const float w0 = F.ssm_conv_w[cw], w1 = F.ssm_conv_w[1536 + cw], w2 = F.ssm_conv_w[2 * 1536 + cw], w3 = F.ssm_conv_w[3 * 1536 + cw], bias = F.ssm_conv_b[cw];
        const bf16* p = PROJ + (size_t)(t0 + 64 * lh) * N1 + col;
        float h0 = 0.f, h1 = 0.f, h2 = 0.f;
        if (!(c == 0 && lh == 0)) { h0 = bf1(p[-3 * N1]); h1 = bf1(p[-2 * N1]); h2 = bf1(p[-1 * N1]); }
        bf16* CN = WSP(bf16, WS_CN);
        for (int st = 0; st < 8; ++st) {
            float raw[8]; unsigned ob[8];
#pragma unroll
            for (int i = 0; i < 8; ++i) raw[i] = bf1(p[(size_t)(st * 8 + i) * N1]);
#pragma unroll
            for (int i = 0; i < 8; ++i) { const float v = w0 * h0 + w1 * h1 + w2 * h2 + w3 * raw[i] + bias; h0 = h1; h1 = h2; h2 = raw[i]; ob[i] = f2bf(silu_f(v)); }
            const int l = 64 * lh + 8 * st;
            if (!isC) {
                v4u pk; pk.x = ob[0] | (ob[1] << 16); pk.y = ob[2] | (ob[3] << 16); pk.z = ob[4] | (ob[5] << 16); pk.w = ob[6] | (ob[7] << 16);
                *(LAS v4u*)(BT + n * RS + l * 2) = pk;
#pragma unroll
                for (int i = 0; i < 8; ++i) *(LAS bf16*)(Bnat + (l + i) * RS + n * 2) = (bf16)ob[i];
            } else {
#pragma unroll
                for (int i = 0; i < 8; ++i) { *(LAS bf16*)(Cnat + (l + i) * RS + n * 2) = (bf16)ob[i]; CN[(size_t)(t0 + l + i) * 256 + 128 * g + n] = (bf16)ob[i]; }
            }
        }
    }
    __syncthreads();
    {
        const int l0 = 16 * wave; bf16x8 cf[4];
#pragma unroll
        for (int ks = 0; ks < 4; ++ks) cf[ks] = *(LAS bf16x8*)(Cnat + (l0 + r) * RS + (32 * ks + 8 * q) * 2);
        bf16* CBG = WSP(bf16, WS_CB) + (size_t)unit * 16384;
#pragma unroll
        for (int st = 0; st < 8; ++st) { f32x4 acc = (f32x4){0.f, 0.f, 0.f, 0.f};
#pragma unroll
            for (int ks = 0; ks < 4; ++ks) { const bf16x8 af = *(LAS bf16x8*)(Bnat + (16 * st + r) * RS + (32 * ks + 8 * q) * 2); acc = mfma16(af, cf[ks], acc); }
            v2u o; o.x = pk2(acc[0], acc[1]); o.y = pk2(acc[2], acc[3]);
            *(v2u*)(CBG + (l0 + r) * 128 + 16 * st + 4 * q) = o; }
    }
    __syncthreads();
    bf16* XT = WSP(bf16, WS_XT);
    for (int rd = 0; rd < 2; ++rd) {
        {
            const int ch = tid & 255, lh = tid >> 8, hl = 4 * rd + (ch >> 6), p_ = ch & 63, head = 8 * g + hl;
            const int col = C_X + 512 * g + 256 * rd + ch, cw = 512 * g + 256 * rd + ch;
            const float w0 = F.ssm_conv_w[cw], w1 = F.ssm_conv_w[1536 + cw], w2 = F.ssm_conv_w[2 * 1536 + cw], w3 = F.ssm_conv_w[3 * 1536 + cw], bias = F.ssm_conv_b[cw];
            const bf16* p = PROJ + (size_t)(t0 + 64 * lh) * N1 + col;
            float h0 = 0.f, h1 = 0.f, h2 = 0.f;
            if (!(c == 0 && lh == 0)) { h0 = bf1(p[-3 * N1]); h1 = bf1(p[-2 * N1]); h2 = bf1(p[-1 * N1]); }
            bf16* xtg = XT + ((size_t)(bc * 16 + head) * 64 + p_) * 128;
            for (int st = 0; st < 8; ++st) {
                float raw[8], ov[8];
#pragma unroll
                for (int i = 0; i < 8; ++i) raw[i] = bf1(p[(size_t)(st * 8 + i) * N1]);
#pragma unroll
                for (int i = 0; i < 8; ++i) { const float v = w0 * h0 + w1 * h1 + w2 * h2 + w3 * raw[i] + bias; h0 = h1; h1 = h2; h2 = raw[i]; ov[i] = silu_f(v); }
                const int l = 64 * lh + 8 * st;
                v4u pk; pk.x = pk2(ov[0], ov[1]); pk.y = pk2(ov[2], ov[3]); pk.z = pk2(ov[4], ov[5]); pk.w = pk2(ov[6], ov[7]);
                *(v4u*)(xtg + l) = pk;
                const f32x4 wa = *(LAS f32x4*)(wts + hl * 128 + l), wb = *(LAS f32x4*)(wts + hl * 128 + l + 4);
                v4u pw; pw.x = pk2(ov[0] * wa.x, ov[1] * wa.y); pw.y = pk2(ov[2] * wa.z, ov[3] * wa.w); pw.z = pk2(ov[4] * wb.x, ov[5] * wb.y); pw.w = pk2(ov[6] * wb.z, ov[7] * wb.w);
                *(LAS v4u*)(xwT + ch * RS + l * 2) = pw;
            }
        }
        __syncthreads();
        {
            const int hl2 = wave >> 1, nh = wave & 1, head = 8 * g + 4 * rd + hl2;
            f32x4 acc[4][4];
#pragma unroll
            for (int a = 0; a < 4; ++a)
#pragma unroll
                for (int b2 = 0; b2 < 4; ++b2) acc[a][b2] = (f32x4){0.f, 0.f, 0.f, 0.f};
#pragma unroll
            for (int ks = 0; ks < 4; ++ks) { bf16x8 af[4], bfr[4];
#pragma unroll
                for (int nt = 0; nt < 4; ++nt) af[nt] = *(LAS bf16x8*)(BT + (64 * nh + 16 * nt + r) * RS + (32 * ks + 8 * q) * 2);
#pragma unroll
                for (int pt = 0; pt < 4; ++pt) bfr[pt] = *(LAS bf16x8*)(xwT + (64 * hl2 + 16 * pt + r) * RS + (32 * ks + 8 * q) * 2);
#pragma unroll
                for (int nt = 0; nt < 4; ++nt)
#pragma unroll
                    for (int pt = 0; pt < 4; ++pt) acc[nt][pt] = mfma16(af[nt], bfr[pt], acc[nt][pt]); }
            bf16* stg = ST + (size_t)(bc * 16 + head) * 8192;
#pragma unroll
            for (int nt = 0; nt < 4; ++nt)
#pragma unroll
                for (int pt = 0; pt < 4; ++pt) { v2u o; o.x = pk2(acc[nt][pt][0], acc[nt][pt][1]); o.y = pk2(acc[nt][pt][2], acc[nt][pt][3]);
                    *(v2u*)(stg + (16 * pt + r) * 128 + 64 * nh + 16 * nt + 4 * q) = o; }
        }
        __syncthreads();
    }
    {
        const int cg = tid & 63, rs = tid >> 6, ch0 = 512 * g + 8 * cg;
        float w0[8], w1[8], w2[8], nw[8], pm2[8], pm1[8];
#pragma unroll
        for (int e = 0; e < 8; ++e) { w0[e] = F.sc_conv_w[ch0 + e]; w1[e] = F.sc_conv_w[1024 + ch0 + e]; w2[e] = F.sc_conv_w[2048 + ch0 + e]; nw[e] = F.sc_norm_w[ch0 + e]; pm2[e] = 0.f; pm1[e] = 0.f; }
        bf16* P = WSP(bf16, WS_PROJ) + (size_t)(t0 + 16 * rs) * N1 + ch0;
        if (!(c == 0 && rs == 0)) {
            const v4u c2 = *(const v4u*)(P - 2 * N1 + C_SCC), hh2 = *(const v4u*)(P - 2 * N1 + C_SCH), c1 = *(const v4u*)(P - N1 + C_SCC), hh1 = *(const v4u*)(P - N1 + C_SCH);
            pm2[0] = bflo(c2.x) * bflo(hh2.x); pm2[1] = bfhi(c2.x) * bfhi(hh2.x); pm2[2] = bflo(c2.y) * bflo(hh2.y); pm2[3] = bfhi(c2.y) * bfhi(hh2.y);
            pm2[4] = bflo(c2.z) * bflo(hh2.z); pm2[5] = bfhi(c2.z) * bfhi(hh2.z); pm2[6] = bflo(c2.w) * bflo(hh2.w); pm2[7] = bfhi(c2.w) * bfhi(hh2.w);
            pm1[0] = bflo(c1.x) * bflo(hh1.x); pm1[1] = bfhi(c1.x) * bfhi(hh1.x); pm1[2] = bflo(c1.y) * bflo(hh1.y); pm1[3] = bfhi(c1.y) * bfhi(hh1.y);
            pm1[4] = bflo(c1.z) * bflo(hh1.z); pm1[5] = bfhi(c1.z) * bfhi(hh1.z); pm1[6] = bflo(c1.w) * bflo(hh1.w); pm1[7] = bfhi(c1.w) * bfhi(hh1.w);
        }
        for (int i = 0; i < 16; ++i) {
            bf16* row = P + (size_t)i * N1;
            const v4u bv = *(const v4u*)(row + C_SCB), cv = *(const v4u*)(row + C_SCC), hv = *(const v4u*)(row + C_SCH);
            float pr[8], bb[8], y[8];
            pr[0] = bflo(cv.x) * bflo(hv.x); pr[1] = bfhi(cv.x) * bfhi(hv.x); pr[2] = bflo(cv.y) * bflo(hv.y); pr[3] = bfhi(cv.y) * bfhi(hv.y);
            pr[4] = bflo(cv.z) * bflo(hv.z); pr[5] = bfhi(cv.z) * bfhi(hv.z); pr[6] = bflo(cv.w) * bflo(hv.w); pr[7] = bfhi(cv.w) * bfhi(hv.w);
            bb[0] = bflo(bv.x); bb[1] = bfhi(bv.x); bb[2] = bflo(bv.y); bb[3] = bfhi(bv.y); bb[4] = bflo(bv.z); bb[5] = bfhi(bv.z); bb[6] = bflo(bv.w); bb[7] = bfhi(bv.w);
            float ss = 0.f;
#pragma unroll
            for (int e = 0; e < 8; ++e) { y[e] = (w0[e] * pm2[e] + w1[e] * pm1[e] + w2[e] * pr[e]) * bb[e]; ss += y[e] * y[e]; pm2[e] = pm1[e]; pm1[e] = pr[e]; }
            ss += __shfl_xor(ss, 1); ss += __shfl_xor(ss, 2); ss += __shfl_xor(ss, 4);
            const float rstd = rsqrtf(ss * (1.0f / 64.0f) + RMS_EPS);
            v4u o; o.x = pk2(y[0] * rstd * nw[0], y[1] * rstd * nw[1]); o.y = pk2(y[2] * rstd * nw[2], y[3] * rstd * nw[3]);
            o.z = pk2(y[4] * rstd * nw[4], y[5] * rstd * nw[5]); o.w = pk2(y[6] * rstd * nw[6], y[7] * rstd * nw[7]);
            *(v4u*)(row + C_SCB) = o;
        }
    }
    __syncthreads();
}

__device__ __forceinline__ void p4_scan(Frame& F, bf16* ST) {
    const float* ACUM = WSP(const float, WS_ACUM);
    for (int e = F.bid * NT + F.tid; e < NB * 16 * 2048; e += F.G * NT) {
        const int b = e >> 15, h = (e >> 11) & 15, pn4 = e & 2047;
        bf16* base = ST + ((size_t)(b * NCH) * 16 + h) * 8192 + pn4 * 4;
        float run[4] = {0.f, 0.f, 0.f, 0.f};
        for (int c0 = 0; c0 < NCH; c0 += 8) {
            v2u s[8]; float dec[8];
#pragma unroll
            for (int k = 0; k < 8; ++k) { s[k] = *(const v2u*)(base + (size_t)(c0 + k) * 131072); dec[k] = ACUM[(size_t)(b * SEQ + (c0 + k) * LCH + 127) * 16 + h]; }
#pragma unroll
            for (int k = 0; k < 8; ++k) { const float d = __expf(dec[k]);
                v2u o; o.x = pk2(run[0], run[1]); o.y = pk2(run[2], run[3]); *(v2u*)(base + (size_t)(c0 + k) * 131072) = o;
                run[0] = run[0] * d + bflo(s[k].x); run[1] = run[1] * d + bfhi(s[k].x); run[2] = run[2] * d + bflo(s[k].y); run[3] = run[3] * d + bfhi(s[k].y); }
        }
    }
}

__device__ __forceinline__ void p5_unit(Frame& F, int unit, const bf16* ST) {
    const int g = unit & 1, bc = unit >> 1, b = bc >> 5, c = bc & 31, t0 = b * SEQ + c * LCH, tid = F.tid, lane = F.lane, wave = F.wave;
    const int r = lane & 15, q = lane >> 4, l = 16 * wave + r;
    LAS unsigned char* buf0 = F.lds; LAS unsigned char* buf1 = F.lds + 34816;
    LAS float* acum_s = (LAS float*)(F.lds + 69632);
    LAS float* dt_s = acum_s + 1024;
    const float* DT = WSP(const float, WS_DT); const float* ACUM = WSP(const float, WS_ACUM);
    const bf16* XT = WSP(const bf16, WS_XT); bf16* PROJ = WSP(bf16, WS_PROJ);
    for (int i = tid; i < 1024; i += NT) { const int hl = i >> 7, s = i & 127; acum_s[i] = ACUM[(size_t)(t0 + s) * 16 + 8 * g + hl]; dt_s[i] = DT[(size_t)(t0 + s) * 16 + 8 * g + hl]; }
    v4u cbf[4], cf[4];
    {
        const bf16* CBG = WSP(const bf16, WS_CB) + (size_t)unit * 16384; const bf16* CN = WSP(const bf16, WS_CN);
#pragma unroll
        for (int ks = 0; ks < 4; ++ks) { cbf[ks] = *(const v4u*)(CBG + l * 128 + 32 * ks + 8 * q); cf[ks] = *(const v4u*)(CN + (size_t)(t0 + l) * 256 + 128 * g + 32 * ks + 8 * q); }
    }
    v4u sx[2], sp[2];
    const int ci0 = tid, ci1 = tid + 512;
    const int lo0 = (ci0 >> 4) * RS + (ci0 & 15) * 16, lo1 = (ci1 >> 4) * RS + (ci1 & 15) * 16;
#define P5_LOAD(hd) do { const size_t o_ = (size_t)(bc * 16 + (hd)) * 8192; sx[0] = *(const v4u*)(XT + o_ + ci0 * 8); sx[1] = *(const v4u*)(XT + o_ + ci1 * 8); \
        sp[0] = *(const v4u*)(ST + o_ + ci0 * 8); sp[1] = *(const v4u*)(ST + o_ + ci1 * 8); } while (0)
#define P5_WRITE(bufp) do { *(LAS v4u*)((bufp) + lo0) = sx[0]; *(LAS v4u*)((bufp) + lo1) = sx[1]; *(LAS v4u*)((bufp) + 17408 + lo0) = sp[0]; *(LAS v4u*)((bufp) + 17408 + lo1) = sp[1]; } while (0)
    P5_LOAD(8 * g); P5_WRITE(buf0);
    __syncthreads();
    float sumsq = 0.f;
    bf16* zrow = PROJ + (size_t)(t0 + l) * N1 + C_Z + 512 * g;
#pragma unroll 1
    for (int hl = 0; hl < 8; ++hl) {
        const int head = 8 * g + hl; LAS unsigned char* cur = (hl & 1) ? buf1 : buf0; LAS unsigned char* nxtb = (hl & 1) ? buf0 : buf1;
        if (hl < 7) P5_LOAD(head + 1);
        const float acl = acum_s[hl * 128 + l];
        bf16x8 mf[4];
#pragma unroll
        for (int ks = 0; ks < 4; ++ks) { const int s0 = 32 * ks + 8 * q;
            const f32x4 a0 = *(LAS f32x4*)(acum_s + hl * 128 + s0), a1 = *(LAS f32x4*)(acum_s + hl * 128 + s0 + 4), e0 = *(LAS f32x4*)(dt_s + hl * 128 + s0), e1 = *(LAS f32x4*)(dt_s + hl * 128 + s0 + 4);
            const float as[8] = {a0.x, a0.y, a0.z, a0.w, a1.x, a1.y, a1.z, a1.w}, ds[8] = {e0.x, e0.y, e0.z, e0.w, e1.x, e1.y, e1.z, e1.w};
            const unsigned cw[4] = {cbf[ks].x, cbf[ks].y, cbf[ks].z, cbf[ks].w}; float m[8];
#pragma unroll
            for (int j = 0; j < 8; ++j) { const float cbv = (j & 1) ? bfhi(cw[j >> 1]) : bflo(cw[j >> 1]); const bool ok = (s0 + j) <= l; const float seg = ok ? (acl - as[j]) : 0.f; m[j] = ok ? cbv * __expf(seg) * ds[j] : 0.f; }
            v4u pk; pk.x = pk2(m[0], m[1]); pk.y = pk2(m[2], m[3]); pk.z = pk2(m[4], m[5]); pk.w = pk2(m[6], m[7]); mf[ks] = __builtin_bit_cast(bf16x8, pk); }
        f32x4 d1[4], d2[4];
#pragma unroll
        for (int pt = 0; pt < 4; ++pt) { d1[pt] = (f32x4){0.f, 0.f, 0.f, 0.f}; d2[pt] = (f32x4){0.f, 0.f, 0.f, 0.f}; }
#pragma unroll
        for (int ks = 0; ks < 4; ++ks) {
            if (32 * ks <= 16 * wave + 15) {
#pragma unroll
                for (int pt = 0; pt < 4; ++pt) { const bf16x8 af = *(LAS bf16x8*)(cur + (16 * pt + r) * RS + (32 * ks + 8 * q) * 2); d1[pt] = mfma16(af, mf[ks], d1[pt]); } }
#pragma unroll
            for (int pt = 0; pt < 4; ++pt) { const bf16x8 af = *(LAS bf16x8*)(cur + 17408 + (16 * pt + r) * RS + (32 * ks + 8 * q) * 2); d2[pt] = mfma16(af, __builtin_bit_cast(bf16x8, cf[ks]), d2[pt]); }
        }
        const float dfs = __expf(acl), dsk = F.d_skip[head];
#pragma unroll
        for (int pt = 0; pt < 4; ++pt) { const int p0 = 16 * pt + 4 * q;
            const v2u zv = *(const v2u*)(zrow + 64 * hl + p0); const float zf[4] = {bflo(zv.x), bfhi(zv.x), bflo(zv.y), bfhi(zv.y)}; float y[4];
#pragma unroll
            for (int e = 0; e < 4; ++e) { const float xv = bf1(*(LAS bf16*)(cur + (p0 + e) * RS + l * 2)); float v = d1[pt][e] + dfs * d2[pt][e] + dsk * xv; v *= silu_f(zf[e]); sumsq += v * v; y[e] = v; }
            v2u yo; yo.x = pk2(y[0], y[1]); yo.y = pk2(y[2], y[3]); *(v2u*)(zrow + 64 * hl + p0) = yo; }
        if (hl < 7) P5_WRITE(nxtb);
        __syncthreads();
    }
#undef P5_LOAD
#undef P5_WRITE
    sumsq += __shfl_xor(sumsq, 16); sumsq += __shfl_xor(sumsq, 32);
    const float rstd = rsqrtf(sumsq * (1.0f / 512.0f) + RMS_EPS);
    asm volatile("s_waitcnt vmcnt(0)" ::: "memory");
#pragma unroll 2
    for (int hl = 0; hl < 8; ++hl)
#pragma unroll
        for (int pt = 0; pt < 4; ++pt) { const int p0 = 16 * pt + 4 * q; const f32x4 nw = *(const f32x4*)(F.ssm_norm_w + 512 * g + 64 * hl + p0);
            const v2u yv = *(const v2u*)(zrow + 64 * hl + p0);
            v2u o; o.x = pk2(bflo(yv.x) * rstd * nw.x, bfhi(yv.x) * rstd * nw.y); o.y = pk2(bflo(yv.y) * rstd * nw.z, bfhi(yv.y) * rstd * nw.w);
            *(v2u*)(zrow + 64 * hl + p0) = o; }
    __syncthreads();
}

__device__ __forceinline__ void p7_ln1(Frame& F, const float* PRE) {
    const int gw = F.bid * NWAVES + F.wave, NGW = F.G * NWAVES, lane = F.lane;
    const float* COND = WSP(const float, WS_COND); float* X1 = WSP(float, WS_X1); bf16* U2 = WSP(bf16, WS_U2);
    for (int m = gw; m < T; m += NGW) {
        const int b = m >> 12; const float* cd = COND + b * 6144;
        const f32x4* xr = (const f32x4*)(PRE + (size_t)m * D) + lane;
        f32x4 v[4]; float s = 0.f;
#pragma unroll
        for (int j = 0; j < 4; ++j) { v[j] = xr[64 * j]; s += (v[j].x + v[j].y) + (v[j].z + v[j].w); }
        const float mean = wave_sum(s) * (1.f / D); float s2 = 0.f;
#pragma unroll
        for (int j = 0; j < 4; ++j) { v[j] = v[j] - mean; s2 += (v[j].x * v[j].x + v[j].y * v[j].y) + (v[j].z * v[j].z + v[j].w * v[j].w); }
        const float rstd = rsqrtf(wave_sum(s2) * (1.f / D) + LN_EPS);
#pragma unroll
        for (int j = 0; j < 4; ++j) { const int col = 4 * lane + 256 * j;
            const f32x4 gg = *(const f32x4*)(F.ln1_g + col), bb = *(const f32x4*)(F.ln1_b + col), sh = *(const f32x4*)(cd + 3 * 1024 + col), scl = *(const f32x4*)(cd + 4 * 1024 + col);
            const f32x4 x1 = v[j] * rstd * gg + bb; *(f32x4*)(X1 + (size_t)m * D + col) = x1;
            const f32x4 u = x1 * (scl + 1.0f) + sh; v2u o; o.x = pk2(u.x, u.y); o.y = pk2(u.z, u.w); *(v2u*)(U2 + (size_t)m * D + col) = o; }
    }
    const size_t NQ = (size_t)16384 * 1024 / 4;
    v2u* EU = WSP(v2u, WS_EU); v2u* EV = WSP(v2u, WS_EV);
    const f32x4* su = (const f32x4*)F.expert_u; const f32x4* sv = (const f32x4*)F.expert_v;
    const size_t stride = (size_t)F.G * NT;
    for (size_t i = (size_t)F.bid * NT + F.tid; i < NQ; i += 4 * stride) {
        f32x4 a[4], bq[4];
#pragma unroll
        for (int k = 0; k < 4; ++k) { const size_t ii = i + k * stride; if (ii < NQ) { a[k] = su[ii]; bq[k] = sv[ii]; } }
#pragma unroll
        for (int k = 0; k < 4; ++k) { const size_t ii = i + k * stride; if (ii < NQ) { v2u o; o.x = pk2(a[k].x, a[k].y); o.y = pk2(a[k].z, a[k].w); EU[ii] = o; v2u o2; o2.x = pk2(bq[k].x, bq[k].y); o2.y = pk2(bq[k].z, bq[k].w); EV[ii] = o2; } }
    }
}

__device__ __forceinline__ int med3i(int a, int b, int c) { int d; asm("v_med3_i32 %0, %1, %2, %3" : "=v"(d) : "v"(a), "v"(b), "v"(c)); return d; }
__device__ __forceinline__ int ord_key(unsigned bits) { const int s = (int)bits; return s ^ ((s >> 31) & 0x7fffffff); }
#define TOPK_INSERT(L, k) do { _Pragma("unroll") for (int j_ = 15; j_ >= 1; --j_) L[j_] = med3i(L[j_ - 1], L[j_], (k)); L[0] = max(L[0], (k)); } while (0)
__device__ __forceinline__ float gelu_exact(float v) { return 0.5f * v * (1.0f + erff(v * 0.70710678118654752f)); }

__device__ __forceinline__ void p9_block(Frame& F, int tb) {
    const int tid = F.tid, lane = F.lane, wave = F.wave;
    LAS unsigned short* eidx = (LAS unsigned short*)F.lds;
    LAS float* gate = (LAS float*)(F.lds + 16384);
    LAS unsigned char* idxs = F.lds + 49152;
    LAS float* acts = (LAS float*)(F.lds + 65536);
    const bf16* SC = WSP(const bf16, WS_SC);
    {
        int L1[16], L2[16];
#pragma unroll
        for (int j = 0; j < 16; ++j) { L1[j] = (int)0x80000000; L2[j] = (int)0x80000000; }
        const bf16* s1p = SC + ((((size_t)tb * 16 + 2 * wave) * 16) * 64 + lane) * 8;
        const bf16* s2p = s1p + (size_t)16 * 64 * 8;
        for (int kc = 0; kc < 16; kc += 4) {
            v4u a[4], bq[4];
#pragma unroll
            for (int u = 0; u < 4; ++u) { a[u] = *(const v4u*)(s1p + (size_t)(kc + u) * 512); bq[u] = *(const v4u*)(s2p + (size_t)(kc + u) * 512); }
#pragma unroll
            for (int u = 0; u < 4; ++u) {
                const unsigned wa[4] = {a[u].x, a[u].y, a[u].z, a[u].w}, wb[4] = {bq[u].x, bq[u].y, bq[u].z, bq[u].w};
#pragma unroll
                for (int e = 0; e < 8; ++e) { const int idx = 8 * (kc + u) + e;
                    const unsigned b1 = (e & 1) ? (wa[e >> 1] & 0xffff0000u) : (wa[e >> 1] << 16), b2 = (e & 1) ? (wb[e >> 1] & 0xffff0000u) : (wb[e >> 1] << 16);
                    const int k1 = (ord_key(b1) & ~127) | (127 - idx), k2 = (ord_key(b2) & ~127) | (127 - idx);
                    TOPK_INSERT(L1, k1); TOPK_INSERT(L2, k2); }
            }
        }
        float v1[16], v2[16]; unsigned ib[8];
#pragma unroll
        for (int j = 0; j < 8; ++j) ib[j] = 0u;
#pragma unroll
        for (int j = 0; j < 16; ++j) { v1[j] = __builtin_bit_cast(float, (unsigned)ord_key((unsigned)L1[j]) & 0xffff0000u); v2[j] = __builtin_bit_cast(float, (unsigned)ord_key((unsigned)L2[j]) & 0xffff0000u);
            ib[j >> 2] |= (unsigned)(127 - (L1[j] & 127)) << (8 * (j & 3)); ib[4 + (j >> 2)] |= (unsigned)(127 - (L2[j] & 127)) << (8 * (j & 3)); }
        LAS unsigned char* myidx = idxs + (wave * 64 + lane) * 32;
        { v4u o0, o1; o0.x = ib[0]; o0.y = ib[1]; o0.z = ib[2]; o0.w = ib[3]; o1.x = ib[4]; o1.y = ib[5]; o1.z = ib[6]; o1.w = ib[7]; *(LAS v4u*)myidx = o0; *(LAS v4u*)(myidx + 16) = o1; }
        int Fk[16];
#pragma unroll
        for (int j = 0; j < 16; ++j) Fk[j] = (int)0x80000000;
#pragma unroll
        for (int a = 0; a < 16; ++a)
#pragma unroll
            for (int b2 = 0; b2 < 16; ++b2)
                if ((a + 1) * (b2 + 1) <= 16) { const float sm = v1[a] + v2[b2]; const int k = (ord_key(__builtin_bit_cast(unsigned, sm)) & ~255) | (255 - (a * 16 + b2)); TOPK_INSERT(Fk, k); }
        LDS_WAIT(); asm volatile("" ::: "memory");
        float sv[16], ssum = 0.f;
#pragma unroll
        for (int j = 0; j < 16; ++j) sv[j] = __builtin_bit_cast(float, (unsigned)ord_key((unsigned)Fk[j]));
        const float smax = sv[0];
#pragma unroll
        for (int j = 0; j < 16; ++j) { sv[j] = __expf(sv[j] - smax); ssum += sv[j]; }
        const float inv = 1.0f / ssum;
#pragma unroll
        for (int j = 0; j < 16; ++j) { const int ab = 255 - (Fk[j] & 255); const int i1 = myidx[ab >> 4], i2 = myidx[16 + (ab & 15)];
            eidx[lane * 128 + wave * 16 + j] = (unsigned short)(i1 * 128 + i2); gate[lane * 128 + wave * 16 + j] = sv[j] * inv; }
    }
    __syncthreads();
    const bf16* U2 = WSP(const bf16, WS_U2); const bf16* EU = WSP(const bf16, WS_EU); const bf16* EV = WSP(const bf16, WS_EV);
    const float* X1 = WSP(const float, WS_X1); const float* COND = WSP(const float, WS_COND);
    const int q = lane >> 4, j16 = lane & 15;
    for (int tk = wave; tk < 64; tk += NWAVES) {
        const int t = tb * 64 + tk, b = t >> 12;
        v4u xr[8];
#pragma unroll
        for (int i = 0; i < 8; ++i) xr[i] = *(const v4u*)(U2 + (size_t)t * D + 128 * i + 8 * j16);
        for (int it = 0; it < 32; it += 2) {
            const int sl0 = 4 * it + q, sl1 = sl0 + 4;
            const int e0 = eidx[tk * 128 + sl0], e1 = eidx[tk * 128 + sl1];
            const bf16* r0 = EU + (size_t)e0 * D + 8 * j16; const bf16* r1 = EU + (size_t)e1 * D + 8 * j16;
            v4u w0[8], w1[8];
#pragma unroll
            for (int i = 0; i < 8; ++i) { w0[i] = *(const v4u*)(r0 + 128 * i); w1[i] = *(const v4u*)(r1 + 128 * i); }
            float a0 = 0.f, a1 = 0.f, c0 = 0.f, c1 = 0.f;
#pragma unroll
            for (int i = 0; i < 8; ++i) { a0 = dot2_bf16(w0[i].x, xr[i].x, a0); a1 = dot2_bf16(w0[i].y, xr[i].y, a1); a0 = dot2_bf16(w0[i].z, xr[i].z, a0); a1 = dot2_bf16(w0[i].w, xr[i].w, a1);
                c0 = dot2_bf16(w1[i].x, xr[i].x, c0); c1 = dot2_bf16(w1[i].y, xr[i].y, c1); c0 = dot2_bf16(w1[i].z, xr[i].z, c0); c1 = dot2_bf16(w1[i].w, xr[i].w, c1); }
            float h0 = a0 + a1, h1 = c0 + c1;
#pragma unroll
            for (int o = 1; o < 16; o <<= 1) { h0 += __shfl_xor(h0, o); h1 += __shfl_xor(h1, o); }
            if (j16 == 0) { acts[wave * 128 + sl0] = gelu_exact(h0) * gate[tk * 128 + sl0]; acts[wave * 128 + sl1] = gelu_exact(h1) * gate[tk * 128 + sl1]; }
        }
        LDS_WAIT(); asm volatile("" ::: "memory");
        float acc[16];
#pragma unroll
        for (int k = 0; k < 16; ++k) acc[k] = 0.f;
        for (int e = 0; e < 128; e += 4) {
            v4u lo[4], hi[4]; float av[4];
#pragma unroll
            for (int u = 0; u < 4; ++u) { const int ex = eidx[tk * 128 + e + u]; const bf16* rp = EV + (size_t)ex * D + 8 * lane; lo[u] = *(const v4u*)rp; hi[u] = *(const v4u*)(rp + 512); av[u] = acts[wave * 128 + e + u]; }
#pragma unroll
            for (int u = 0; u < 4; ++u) { const float a = av[u];
                acc[0] += a * bflo(lo[u].x); acc[1] += a * bfhi(lo[u].x); acc[2] += a * bflo(lo[u].y); acc[3] += a * bfhi(lo[u].y);
                acc[4] += a * bflo(lo[u].z); acc[5] += a * bfhi(lo[u].z); acc[6] += a * bflo(lo[u].w); acc[7] += a * bfhi(lo[u].w);
                acc[8] += a * bflo(hi[u].x); acc[9] += a * bfhi(hi[u].x); acc[10] += a * bflo(hi[u].y); acc[11] += a * bfhi(hi[u].y);
                acc[12] += a * bflo(hi[u].z); acc[13] += a * bfhi(hi[u].z); acc[14] += a * bflo(hi[u].w); acc[15] += a * bfhi(hi[u].w); }
        }
        const float* x1p = X1 + (size_t)t * D + 8 * lane; const float* g2 = COND + b * 6144 + 5 * 1024 + 8 * lane;
        float rv[16]; float s = 0.f;
#pragma unroll
        for (int hf = 0; hf < 2; ++hf)
#pragma unroll
            for (int k4 = 0; k4 < 2; ++k4) { const f32x4 xv = *(const f32x4*)(x1p + 512 * hf + 4 * k4), gv = *(const f32x4*)(g2 + 512 * hf + 4 * k4);
#pragma unroll
                for (int e = 0; e < 4; ++e) { const float v = ALPHA * xv[e] + (1.0f + gv[e]) * acc[8 * hf + 4 * k4 + e]; rv[8 * hf + 4 * k4 + e] = v; s += v; } }
        const float mean = wave_sum(s) * (1.f / D); float s2 = 0.f;
#pragma unroll
        for (int k = 0; k < 16; ++k) { rv[k] -= mean; s2 += rv[k] * rv[k]; }
        const float rstd = rsqrtf(wave_sum(s2) * (1.f / D) + LN_EPS);
        float* op = F.out + (size_t)t * D + 8 * lane;
#pragma unroll
        for (int hf = 0; hf < 2; ++hf)
#pragma unroll
            for (int k4 = 0; k4 < 2; ++k4) { const f32x4 gg = *(const f32x4*)(F.ln2_g + 8 * lane + 512 * hf + 4 * k4), bb = *(const f32x4*)(F.ln2_b + 8 * lane + 512 * hf + 4 * k4); f32x4 o;
#pragma unroll
                for (int e = 0; e < 4; ++e) o[e] = rv[8 * hf + 4 * k4 + e] * rstd * gg[e] + bb[e];
                *(f32x4*)(op + 512 * hf + 4 * k4) = o; }
    }
    __syncthreads();
}

constexpr int N_PHASES = 10;
struct Args { const float* in[23]; float* out; unsigned char* ws; int ph_lo, ph_hi; };
__global__ void __launch_bounds__(NT, 2) fwd_kernel(Args args) {
    extern __shared__ __attribute__((aligned(16))) unsigned char lds[];
    Frame F;
    F.lds = (LAS unsigned char*)lds;
    F.tid = threadIdx.x; F.lane = F.tid & 63; F.wave = __builtin_amdgcn_readfirstlane(F.tid >> 6);
    F.G = gridDim.x; F.bid = blockIdx.x;
    F.x = args.in[0]; F.c = args.in[1]; F.w_cond = args.in[2]; F.b_cond = args.in[3]; F.w_in = args.in[4]; F.sc_conv_w = args.in[5]; F.ssm_conv_w = args.in[6]; F.ssm_conv_b = args.in[7];
    F.dt_bias = args.in[8]; F.a_log = args.in[9]; F.d_skip = args.in[10]; F.sc_norm_w = args.in[11]; F.ssm_norm_w = args.in[12]; F.w_out = args.in[13]; F.ln1_g = args.in[14]; F.ln1_b = args.in[15];
    F.w_query = args.in[16]; F.sub_keys1 = args.in[17]; F.sub_keys2 = args.in[18]; F.expert_u = args.in[19]; F.expert_v = args.in[20]; F.ln2_g = args.in[21]; F.ln2_b = args.in[22];
    F.out = args.out; F.ws = args.ws;
    volatile LAS unsigned* MISC = (volatile LAS unsigned*)(F.lds + LDS_MISC);
    if (F.tid < 16) MISC[F.tid] = 0u;
    __syncthreads();
    const int lo = args.ph_lo, hi = args.ph_hi;
    XcdBarrier bar; bar.bar = (unsigned*)(F.ws + WS_CTL); bar.x = 0; bar.st = nullptr;
    if (hi - lo > 1) bar = xcd_barrier_post((unsigned*)(F.ws + WS_CTL), MISC + 8);
#ifndef PH_MASK
#define PH_MASK 0x3ff
#endif
#define IN(k) ((((PH_MASK) >> (k)) & 1) && lo <= (k) && (k) < hi)
#define SEAM(k) do { if (IN(k) && IN((k) + 1)) xcd_barrier(bar); } while (0)
    bf16* U1 = (bf16*)F.out; bf16* ST = (bf16*)F.out; float* PRE = F.out;
    if (IN(0)) { p0_prologue(F); } SEAM(0);
    if (IN(1)) { p1_modulate(F, U1); } SEAM(1);
    if (IN(2)) {
        pg8::Gemm g{U1, WSP(bf16, WS_WIN), T, N1, D, D, D, 1 << 30, 0}; pg8::StaticOrder S; S.init(T, N1, F.G, F.bid);
        pg8::EpiBf16 E{WSP(bf16, WS_PROJ), N1};
        pg8::gemm_phase<pg8::EpiBf16, pg8::StaticOrder>(F.lds, g, S, E);
    } SEAM(2);
    if (IN(3)) { for (int u = F.bid; u < NB * NCH * 2; u += F.G) p3_unit(F, u, ST); } SEAM(3);
    if (IN(4)) { p4_scan(F, ST); } SEAM(4);
    if (IN(5)) { for (int u = F.bid; u < NB * NCH * 2; u += F.G) p5_unit(F, u, ST); } SEAM(5);
    if (IN(6)) {
        pg8::Gemm g{WSP(bf16, WS_PROJ), WSP(bf16, WS_WOUT), T, D, 2048, N1, 2048, 16, (C_Z - 1024) * 2}; pg8::StaticOrder S; S.init(T, D, F.G, F.bid);
        pg8::EpiPre E{F.x, WSP(float, WS_COND) + 2 * 1024, PRE, ALPHA};
        pg8::gemm_phase<pg8::EpiPre, pg8::StaticOrder>(F.lds, g, S, E);
    } SEAM(6);
    if (IN(7)) { p7_ln1(F, PRE); } SEAM(7);
    if (IN(8)) {
        pg8::Gemm g{WSP(bf16, WS_U2), WSP(bf16, WS_WQ), T, 2048, D, D, D, 1 << 30, 0}; pg8::StaticOrder S; S.init(T, 2048, F.G, F.bid);
        pg8::EpiScores E{WSP(bf16, WS_SC)};
        pg8::gemm_phase<pg8::EpiScores, pg8::StaticOrder>(F.lds, g, S, E);
    } SEAM(8);
    if (IN(9)) { for (int tb = F.bid; tb < T / 64; tb += F.G) p9_block(F, tb); }
#undef IN
#undef SEAM
}

extern "C" void kernel_launch(void* const* d_in, const int* in_sizes, int n_in, void* d_out, int out_size, void* d_ws, size_t ws_size, hipStream_t stream) {
    static int grid = 0;
    if (grid == 0) {
        if (n_in != 23 || out_size != T * D || ws_size < WS_END) { fprintf(stderr, "kernel_launch: unexpected shapes: n_in %d out %d ws %zu\n", n_in, out_size, ws_size); grid = -1; return; }
        int dev = 0, cus = 0, per_cu = 0;
        if (hipGetDevice(&dev) != hipSuccess || hipDeviceGetAttribute(&cus, hipDeviceAttributeMultiprocessorCount, dev) != hipSuccess) { grid = -1; return; }
        if (hipFuncSetAttribute((const void*)fwd_kernel, hipFuncAttributeMaxDynamicSharedMemorySize, LDS_BYTES) != hipSuccess) { fprintf(stderr, "kernel_launch: hipFuncSetAttribute failed\n"); grid = -1; return; }
        if (hipOccupancyMaxActiveBlocksPerMultiprocessor(&per_cu, (const void*)fwd_kernel, NT, LDS_BYTES) != hipSuccess || per_cu < 1) { fprintf(stderr, "kernel_launch: occupancy query says %d\n", per_cu); (void)hipGetLastError(); grid = -1; return; }
        grid = cus;
    }
    if (grid < 0) return;
    (void)hipMemsetAsync((char*)d_ws + WS_CTL, 0, CTL_ZERO_BYTES, stream);
    Args a{};
    for (int i = 0; i < 23; ++i) a.in[i] = (const float*)d_in[i];
    a.out = (float*)d_out; a.ws = (unsigned char*)d_ws;
#if MK_N_LAUNCHES == 1
    a.ph_lo = 0; a.ph_hi = N_PHASES;
    hipLaunchKernelGGL(fwd_kernel, dim3(grid), dim3(NT), LDS_BYTES, stream, a);
#else
    for (int p = 0; p < N_PHASES; ++p) { a.ph_lo = p; a.ph_hi = p + 1; hipLaunchKernelGGL(fwd_kernel, dim3(grid), dim3(NT), LDS_BYTES, stream, a); }
#endif
}
```

```cpp
#include <hip/hip_runtime.h>
#include <cstdio>
#include <cstdint>

#ifndef MK_N_LAUNCHES
#define MK_N_LAUNCHES 1
#endif

namespace pg8 {
#define PG8_LAS __attribute__((address_space(3)))
typedef unsigned short bf16_t;
typedef short bf16x8 __attribute__((ext_vector_type(8)));
typedef float f32x4 __attribute__((ext_vector_type(4)));
typedef unsigned u32x4 __attribute__((ext_vector_type(4)));
constexpr int BM = 256, BK = 64, HALF = 128, HTB = HALF * BK * 2  , STAGE_BYTES = 8 * HTB, NXCD = 8, WGM = 8;

__host__ __device__ __forceinline__ int lds_byte(int r, int c) { const int st = (r >> 4) * 2 + (c >> 5), rr = r & 15, cc = c & 31, ob = rr * 64 + cc * 2; return st * 1024 + (ob ^ (((ob >> 9) & 1) << 5)); }
__host__ __device__ __forceinline__ void stage_rc(int b, int& R, int& C) { const int st = b / 1024, sb = b % 1024, swz = sb ^ (((sb >> 9) & 1) << 5); R = (st >> 1) * 16 + swz / 64; C = (st & 1) * 32 + (swz % 64) / 2; }
__host__ __device__ __forceinline__ int perm32(int rho) { const int n = rho >> 4, i = rho & 15; return 8 * (i >> 2) + 4 * n + (i & 3); }

struct Unit { int pm, pn; };
struct Gemm { const bf16_t* A; const bf16_t* Bt; int M, N, K, lda, ldb, ksplit, kjump; };

struct StaticOrder {
    int nM, nN, nwg, G, c;
    __host__ __device__ void init(int M, int N, int G_, int c_) { nM = M / BM; nN = N / BM; nwg = nM * nN; G = G_; c = c_; }
    __host__ __device__ bool next(int i, Unit& u) const {
        const long L = (long)i * G + c; if (L >= nwg) return false;
        int wgid = (int)L; { const int q = nwg / NXCD, r = nwg % NXCD, xcd = wgid % NXCD, off = wgid / NXCD; wgid = (xcd < r ? xcd * (q + 1) : r * (q + 1) + (xcd - r) * q) + off; }
        const int nig = WGM * nN, gid = wgid / nig, fm = gid * WGM, gsz = (nM - fm) < WGM ? (nM - fm) : WGM;
        u.pm = fm + ((wgid % nig) % gsz); u.pn = (wgid % nig) / gsz; return true;
    }
    __device__ __forceinline__ void a_ready(const Unit&) const {}
    __device__ __forceinline__ void done(const Unit&) const {}
};

__device__ __forceinline__ unsigned cvt_pk_bf16(float lo, float hi) { unsigned r; asm volatile("v_cvt_pk_bf16_f32 %0, %1, %2" : "=v"(r) : "v"(lo), "v"(hi)); return r; }

struct EpiBf16 {
    static constexpr bool PERM = true;
    bf16_t* O; int ldc;
    __device__ __forceinline__ void operator()(const f32x4 (&acc)[2][2][4][2], const Unit& u, int wr, int wc, int fr, int fq) const {
        const int row0 = u.pm * BM + wr * 64 + fr; const int col0 = u.pn * BM + wc * 32 + 8 * fq;
#pragma unroll
        for (int ai = 0; ai < 2; ++ai)
#pragma unroll
            for (int m = 0; m < 4; ++m) { bf16_t* rowp = O + (size_t)(row0 + ai * HALF + m * 16) * ldc + col0;
#pragma unroll
                for (int bj = 0; bj < 2; ++bj) { const f32x4 v0 = acc[ai][bj][m][0], v1 = acc[ai][bj][m][1];
                    u32x4 w; w.x = cvt_pk_bf16(v0[0], v0[1]); w.y = cvt_pk_bf16(v0[2], v0[3]); w.z = cvt_pk_bf16(v1[0], v1[1]); w.w = cvt_pk_bf16(v1[2], v1[3]);
                    *(u32x4*)(rowp + bj * HALF) = w; } }
    }
};
struct EpiScores {
    static constexpr bool PERM = true;
    bf16_t* O;
    __device__ __forceinline__ void operator()(const f32x4 (&acc)[2][2][4][2], const Unit& u, int wr, int wc, int fr, int fq) const {
        const int kc = 4 * wc + fq;
#pragma unroll
        for (int ai = 0; ai < 2; ++ai)
#pragma unroll
            for (int m = 0; m < 4; ++m) { const int r = u.pm * BM + ai * HALF + wr * 64 + m * 16 + fr; const int tb = r >> 6, tok = r & 63;
#pragma unroll
                for (int bj = 0; bj < 2; ++bj) { const f32x4 v0 = acc[ai][bj][m][0], v1 = acc[ai][bj][m][1]; const int hh = 2 * u.pn + bj;
                    u32x4 w; w.x = cvt_pk_bf16(v0[0], v0[1]); w.y = cvt_pk_bf16(v0[2], v0[3]); w.z = cvt_pk_bf16(v1[0], v1[1]); w.w = cvt_pk_bf16(v1[2], v1[3]);
                    *(u32x4*)(O + ((((size_t)tb * 16 + hh) * 16 + kc) * 64 + tok) * 8) = w; } }
    }
};
struct EpiPre {
    static constexpr bool PERM = false;
    const float* x; const float* gate; float* out; float alpha;
    __device__ __forceinline__ void operator()(const f32x4 (&acc)[2][2][4][2], const Unit& u, int wr, int wc, int fr, int fq) const {
        const int row0 = u.pm * BM + wr * 64 + fr, col0 = u.pn * BM + wc * 32 + 4 * fq; const int b = (u.pm * BM) >> 12;
        f32x4 gv[2][2];
#pragma unroll
        for (int bj = 0; bj < 2; ++bj)
#pragma unroll
            for (int n = 0; n < 2; ++n) gv[bj][n] = *(const f32x4*)(gate + b * 6144 + col0 + bj * HALF + n * 16) + 1.0f;
#pragma unroll
        for (int ai = 0; ai < 2; ++ai)
#pragma unroll
            for (int m = 0; m < 4; ++m) { const size_t off = (size_t)(row0 + ai * HALF + m * 16) * 1024 + col0;
#pragma unroll
                for (int bj = 0; bj < 2; ++bj)
#pragma unroll
                    for (int n = 0; n < 2; ++n) { const f32x4 xv = *(const f32x4*)(x + off + bj * HALF + n * 16);
                        *(f32x4*)(out + off + bj * HALF + n * 16) = xv * alpha + gv[bj][n] * acc[ai][bj][m][n]; }
                asm volatile("" ::: "memory"); }
    }
};

template <class Epi, class Sched, bool ALIGN_EPI = true>
__device__ __forceinline__ void gemm_phase(PG8_LAS unsigned char* lds, const Gemm g, const Sched& S, const Epi& E) {
    const int tid = threadIdx.x, wid = __builtin_amdgcn_readfirstlane(tid >> 6), lane = tid & 63, wr = wid >> 2, wc = wid & 3, fr = lane & 15, fq = lane >> 4;
    const int K = g.K, nt = K / BK;
    unsigned voffA[2], voffB[2];
#pragma unroll
    for (int i = 0; i < 2; ++i) { int R, C; stage_rc(tid * 16 + i * 8192, R, C); const int Rb = Epi::PERM ? ((R & ~31) + perm32(R & 31)) : R;
        voffA[i] = (unsigned)(R * g.lda + C) * 2u; voffB[i] = (unsigned)(Rb * g.ldb + C) * 2u; }
    const size_t kstep = (size_t)(BK * 2);
    const size_t hstepA = (size_t)HALF * g.lda * 2, hstepB = (size_t)HALF * g.ldb * 2;
    const size_t tstepA = 2 * hstepA, tstepB = 2 * hstepB;
    const unsigned ldsw = (unsigned)wid * 1024u;
    const int aoff = lds_byte(wr * 64 + fr, fq * 8), boff = lds_byte(wc * 32 + fr, fq * 8);
#define PG8_SA(b, h) (((b) * 2 + (h)) * HTB)
#define PG8_SB(b, h) ((4 + (b) * 2 + (h)) * HTB)
#define PG8_STAGE(bufoff, gbase, voff) do { _Pragma("unroll") for (int _i = 0; _i < 2; ++_i) \
        __builtin_amdgcn_global_load_lds((const unsigned*)((const char*)(gbase) + (voff)[_i]), (PG8_LAS unsigned*)(lds + (bufoff) + ldsw + _i * 8192), 16, 0, 0); } while (0)
#define PG8_LDA(dst, b, h) do { _Pragma("unroll") for (int m = 0; m < 4; ++m) _Pragma("unroll") for (int k = 0; k < 2; ++k) dst[m][k] = *(const PG8_LAS bf16x8*)(lds + PG8_SA(b, h) + aoff + m * 2048 + k * 1024); } while (0)
#define PG8_LDB(dst, b, h) do { _Pragma("unroll") for (int n = 0; n < 2; ++n) _Pragma("unroll") for (int k = 0; k < 2; ++k) dst[n][k] = *(const PG8_LAS bf16x8*)(lds + PG8_SB(b, h) + boff + n * 2048 + k * 1024); } while (0)
#define PG8_MMA(ai, bj, At, Bt) do { __builtin_amdgcn_s_setprio(1); _Pragma("unroll") for (int m = 0; m < 4; ++m) _Pragma("unroll") for (int n = 0; n < 2; ++n) _Pragma("unroll") for (int k = 0; k < 2; ++k) \
        acc[ai][bj][m][n] = __builtin_amdgcn_mfma_f32_16x16x32_bf16(Bt[n][k], At[m][k], acc[ai][bj][m][n], 0, 0, 0); __builtin_amdgcn_s_setprio(0); } while (0)
#define PG8_WAIT_V(n) asm volatile("s_waitcnt vmcnt(" #n ")" ::: "memory")
#define PG8_WAIT_L(n) asm volatile("s_waitcnt lgkmcnt(" #n ")" ::: "memory")
#define PG8_BAR __builtin_amdgcn_s_barrier()
#define PG8_SCHED __builtin_amdgcn_sched_barrier(0)
#define PG8_AT(base, t) ((base) + (size_t)(t) * kstep + ((t) >= g.ksplit ? (size_t)g.kjump : (size_t)0))
    Unit cur, nxt; int ui = 0;
    if (!S.next(0, cur)) return;
    f32x4 acc[2][2][4][2];
#pragma unroll
    for (int a = 0; a < 2; ++a)
#pragma unroll
        for (int b = 0; b < 2; ++b)
#pragma unroll
            for (int m = 0; m < 4; ++m)
#pragma unroll
                for (int n = 0; n < 2; ++n) acc[a][b][m][n] = (f32x4){0.f, 0.f, 0.f, 0.f};
    bf16x8 At[4][2], B0[2][2], B1[2][2];
    const char* cA = (const char*)g.A + (size_t)cur.pm * tstepA; const char* cB = (const char*)g.Bt + (size_t)cur.pn * tstepB;
    S.a_ready(cur);
    PG8_STAGE(PG8_SB(0, 0), cB, voffB); PG8_STAGE(PG8_SB(0, 1), cB + hstepB, voffB); PG8_STAGE(PG8_SA(0, 0), cA, voffA); PG8_STAGE(PG8_SA(0, 1), cA + hstepA, voffA);
    if (wr == 1) PG8_BAR;
    PG8_WAIT_V(2); PG8_BAR;
    PG8_STAGE(PG8_SB(1, 0), cB + kstep, voffB); PG8_STAGE(PG8_SA(1, 0), cA + kstep, voffA); PG8_STAGE(PG8_SB(1, 1), cB + hstepB + kstep, voffB);
    PG8_WAIT_V(6); PG8_BAR;
    for (;;) {
        const bool has_next = S.next(ui + 1, nxt);
        const char* nA = has_next ? (const char*)g.A + (size_t)nxt.pm * tstepA : cA; const char* nB = has_next ? (const char*)g.Bt + (size_t)nxt.pn * tstepB : cB;
        for (int t = 0; t < nt; t += 2) {
            const bool last = (t == nt - 2);
            const char* a1 = PG8_AT(cA, t + 1);
            const char* a2 = last ? nA : PG8_AT(cA, t + 2); const char* b2 = last ? nB : cB + (size_t)(t + 2) * kstep;
            const char* a3 = a2 + kstep; const char* b3 = b2 + kstep;
            if (last && has_next) S.a_ready(nxt);
            PG8_LDB(B0, 0, 0); PG8_LDB(B1, 0, 1); PG8_SCHED; PG8_LDA(At, 0, 0); PG8_STAGE(PG8_SA(1, 1), a1 + hstepA, voffA);
            PG8_WAIT_V(8); PG8_WAIT_L(0); PG8_BAR; PG8_MMA(0, 0, At, B0); PG8_MMA(0, 1, At, B1); PG8_BAR; PG8_SCHED;
            PG8_LDA(At, 0, 1); PG8_STAGE(PG8_SB(0, 0), b2, voffB); PG8_STAGE(PG8_SB(0, 1), b2 + hstepB, voffB); PG8_STAGE(PG8_SA(0, 0), a2, voffA);
            PG8_WAIT_V(8); PG8_WAIT_L(0); PG8_BAR; PG8_MMA(1, 0, At, B0); PG8_MMA(1, 1, At, B1); PG8_BAR; PG8_SCHED;
            PG8_LDB(B0, 1, 0); PG8_LDB(B1, 1, 1); PG8_SCHED; PG8_LDA(At, 1, 0); PG8_STAGE(PG8_SA(0, 1), a2 + hstepA, voffA);
            PG8_WAIT_V(8); PG8_WAIT_L(0); PG8_BAR; PG8_MMA(0, 0, At, B0); PG8_MMA(0, 1, At, B1); PG8_BAR; PG8_SCHED;
            PG8_LDA(At, 1, 1); PG8_STAGE(PG8_SB(1, 0), b3, voffB); PG8_STAGE(PG8_SB(1, 1), b3 + hstepB, voffB); PG8_STAGE(PG8_SA(1, 0), a3, voffA);
            PG8_WAIT_V(8); PG8_WAIT_L(0); PG8_BAR; PG8_MMA(1, 0, At, B0); PG8_MMA(1, 1, At, B1); PG8_BAR; PG8_SCHED;
        }
        if constexpr (ALIGN_EPI) { if (wr == 0) PG8_BAR; }
        E(acc, cur, wr, wc, fr, fq); S.done(cur);
        if (!has_next) break;
#pragma unroll
        for (int a = 0; a < 2; ++a)
#pragma unroll
            for (int b = 0; b < 2; ++b)
#pragma unroll
                for (int m = 0; m < 4; ++m)
#pragma unroll
                    for (int n = 0; n < 2; ++n) acc[a][b][m][n] = (f32x4){0.f, 0.f, 0.f, 0.f};
        cur = nxt; cA = nA; cB = nB; ++ui;
        if constexpr (ALIGN_EPI) { if (wr == 1) PG8_BAR; }
    }
    PG8_WAIT_V(0);
    if constexpr (!ALIGN_EPI) { if (wr == 0) PG8_BAR; }
    PG8_BAR;
#undef PG8_SA
#undef PG8_SB
#undef PG8_STAGE
#undef PG8_LDA
#undef PG8_LDB
#undef PG8_MMA
#undef PG8_WAIT_V
#undef PG8_WAIT_L
#undef PG8_BAR
#undef PG8_SCHED
#undef PG8_AT
}
}

constexpr int NWAVES = 8, NT = 512;
constexpr int T = 16384, D = 1024, SEQ = 4096, NB = 4;
constexpr int INW = 5648, N1 = 5632;
constexpr int C_SCB = 0, C_SCC = 1024, C_SCH = 2048, C_Z = 3072, C_X = 4096, C_B = 5120, C_C = 5376, C_DT = 5632;
constexpr int NCH = 32, LCH = 128;
constexpr float ALPHA = 1.189207115f;
constexpr float LN_EPS = 1e-5f, RMS_EPS = 1e-6f;

constexpr size_t MiB = 1024 * 1024;
constexpr size_t WS_CTL = 0, CTL_ZERO_BYTES = 65536;
constexpr size_t WS_COND = 65536;
constexpr size_t WS_WOUT = 1 * MiB;
constexpr size_t WS_WQ = 5 * MiB;
constexpr size_t WS_WIN = 9 * MiB;
constexpr size_t WS_DT = 20 * MiB;
constexpr size_t WS_ACUM = 21 * MiB;
constexpr size_t WS_PROJ = 24 * MiB;
constexpr size_t WS_CN = 200 * MiB;
constexpr size_t WS_CB = 208 * MiB;
constexpr size_t WS_XT = 216 * MiB;
constexpr size_t WS_X1 = 24 * MiB;
constexpr size_t WS_U2 = 88 * MiB;
constexpr size_t WS_SC = 120 * MiB;
constexpr size_t WS_EU = 184 * MiB;
constexpr size_t WS_EV = 216 * MiB;
constexpr size_t WS_EIDX = 9 * MiB;
constexpr size_t WS_GATE = 248 * MiB;
constexpr size_t WS_FFN = 120 * MiB;
constexpr size_t WS_END = 256 * MiB;

constexpr int LDS_BYTES = 147456;
constexpr int LDS_MISC = 143360;

#define GAS __attribute__((address_space(1)))
#define LAS __attribute__((address_space(3)))
typedef unsigned short bf16;
typedef unsigned v4u __attribute__((ext_vector_type(4)));
typedef unsigned v2u __attribute__((ext_vector_type(2)));
typedef float f32x4 __attribute__((ext_vector_type(4)));
typedef short bf16x8 __attribute__((ext_vector_type(8)));
typedef __bf16 bf16x2_t __attribute__((ext_vector_type(2)));
#define LDS_WAIT() asm volatile("s_waitcnt lgkmcnt(0)" ::: "memory")
__device__ __forceinline__ unsigned f2bf(float f) { unsigned u = __builtin_bit_cast(unsigned, f); return (u + 0x7fffu + ((u >> 16) & 1u)) >> 16; }
__device__ __forceinline__ unsigned pk2(float lo, float hi) { return f2bf(lo) | (f2bf(hi) << 16); }
__device__ __forceinline__ float bflo(unsigned u) { return __builtin_bit_cast(float, u << 16); }
__device__ __forceinline__ float bfhi(unsigned u) { return __builtin_bit_cast(float, u & 0xffff0000u); }
__device__ __forceinline__ float bf1(bf16 b) { return __builtin_bit_cast(float, (unsigned)b << 16); }
__device__ __forceinline__ float wave_sum(float v) {
#pragma unroll
    for (int o = 1; o < 64; o <<= 1) v += __shfl_xor(v, o);
    return v;
}
__device__ __forceinline__ float silu_f(float v) { return v / (1.0f + __expf(-v)); }
__device__ __forceinline__ float dot2_bf16(unsigned w, unsigned x, float acc) { return __builtin_amdgcn_fdot2_f32_bf16(__builtin_bit_cast(bf16x2_t, w), __builtin_bit_cast(bf16x2_t, x), acc, false); }
__device__ __forceinline__ f32x4 mfma16(bf16x8 a, bf16x8 b, f32x4 c) { return __builtin_amdgcn_mfma_f32_16x16x32_bf16(a, b, c, 0, 0, 0); }

#define XB_TMO      128
#define XB_XCNT(j)  (256  + 64 * (j))
#define XB_XSUB(j)  (1280 + 64 * (j))
#define XB_XGEN(j)  (2304 + 64 * (j))
#define XB_TOP      3328
#define XB_TOPGEN   3392
#define XCD_BAR_WORDS 3456
#define XB_SPIN_CAP (1u << 18)
__device__ __forceinline__ unsigned xb_ld(unsigned* p)              { return __hip_atomic_load(p, __ATOMIC_RELAXED, __HIP_MEMORY_SCOPE_AGENT); }
__device__ __forceinline__ unsigned xb_add(unsigned* p, unsigned v) { return __hip_atomic_fetch_add(p, v, __ATOMIC_RELAXED, __HIP_MEMORY_SCOPE_AGENT); }
__device__ __forceinline__ unsigned xb_xcc_id() { return (unsigned)__builtin_amdgcn_s_getreg((3 << 11) | 20) & 0xFu; }
#define XB_SPIN(cond, bar) do { unsigned _sp = 0; while (cond) { __builtin_amdgcn_s_sleep(1); \
    if ((++_sp & 255u) == 0u) { if (xb_ld(&(bar)[XB_TMO])) break; if (_sp > XB_SPIN_CAP) { atomicAdd(&(bar)[XB_TMO], 1u); break; } } } } while (0)
struct XcdBarrier { unsigned* bar; unsigned x; volatile LAS unsigned* st; };
__device__ __forceinline__ XcdBarrier xcd_barrier_post(unsigned* bar, volatile LAS unsigned* st) {
    XcdBarrier b; b.bar = bar; b.x = xb_xcc_id(); b.st = st;
    if (threadIdx.x == 0) (void)xb_add(&bar[XB_XCNT(b.x)], 1u);
    return b;
}
__device__ __forceinline__ void xcd_barrier_complete(unsigned* bar, unsigned x, unsigned& nloc, unsigned& nx) {
    const unsigned G = gridDim.x * gridDim.y * gridDim.z;
    unsigned sum, cnt, mine, sp = 0u;
    for (;;) {
        sum = 0u; cnt = 0u; mine = 0u;
#pragma unroll
        for (unsigned j = 0; j < 16; ++j) { const unsigned c = xb_ld(&bar[XB_XCNT(j)]); sum += c; cnt += (c > 0u) ? 1u : 0u; mine = (j == x) ? c : mine; }
        if (sum == G) break;
        __builtin_amdgcn_s_sleep(1);
        if ((++sp & 255u) == 0u) { if (xb_ld(&bar[XB_TMO])) break; if (sp > XB_SPIN_CAP) { atomicAdd(&bar[XB_TMO], 1u); break; } }
    }
    nloc = mine > 0u ? mine : 1u; nx = cnt > 0u ? cnt : 1u;
}
__device__ __forceinline__ void xcd_barrier(const XcdBarrier& b) {
    asm volatile("s_waitcnt vmcnt(0)" ::: "memory");
    __syncthreads();
    if (threadIdx.x == 0) {
        unsigned* bar = b.bar;
        __builtin_amdgcn_s_waitcnt(0);
        unsigned nloc = b.st[0], nx = b.st[1];
        if (nloc == 0u) { xcd_barrier_complete(bar, b.x, nloc, nx); b.st[0] = nloc; b.st[1] = nx; }
        const unsigned old = xb_add(&bar[XB_XSUB(b.x)], 1u);
        const unsigned gen = old / nloc;
        if (old + 1u == (gen + 1u) * nloc) {
            __builtin_amdgcn_fence(__ATOMIC_RELEASE, "agent");
            asm volatile("s_waitcnt vmcnt(0)" ::: "memory");
            const unsigned og = xb_add(&bar[XB_TOP], 1u);
            const unsigned tg = og / nx;
            if (og + 1u == (tg + 1u) * nx) xb_add(&bar[XB_TOPGEN], 1u);
            else XB_SPIN(xb_ld(&bar[XB_TOPGEN]) == tg, bar);
            __builtin_amdgcn_fence(__ATOMIC_ACQUIRE, "agent");
            xb_add(&bar[XB_XGEN(b.x)], 1u);
            asm volatile("s_waitcnt vmcnt(0)" ::: "memory");
        } else {
            XB_SPIN(xb_ld(&bar[XB_XGEN(b.x)]) == gen, bar);
            __builtin_amdgcn_fence(__ATOMIC_ACQUIRE, "agent");
            asm volatile("s_waitcnt vmcnt(0)" ::: "memory");
        }
    }
    __syncthreads();
}

struct Frame {
    LAS unsigned char* lds;
    int tid, lane, wave, G, bid;
    const float *x, *c, *w_cond, *b_cond, *w_in, *sc_conv_w, *ssm_conv_w, *ssm_conv_b, *dt_bias, *a_log, *d_skip, *sc_norm_w, *ssm_norm_w, *w_out, *ln1_g, *ln1_b,
                *w_query, *sub_keys1, *sub_keys2, *expert_u, *expert_v, *ln2_g, *ln2_b;
    float* out; unsigned char* ws;
};

#define WSP(T_, off) ((T_*)(F.ws + (off)))

__device__ __forceinline__ void p0_transpose_item(const float* W, int ldw, int K, int Nn, bf16* WT, LAS float* scr, int item, int lane) {
    const int nblk = Nn / 32, kb = item / nblk, nb = item % nblk, k0 = 64 * kb, n0 = 32 * nb;
#pragma unroll 8
    for (int i = 0; i < 32; ++i) { const int kk = 2 * i + (lane >> 5); scr[kk * 33 + (lane & 31)] = W[(size_t)(k0 + kk) * ldw + n0 + (lane & 31)]; }
    LDS_WAIT(); asm volatile("" ::: "memory");
    const int c = lane & 7;
#pragma unroll
    for (int j = 0; j < 4; ++j) { const int n = (lane >> 3) + 8 * j; const LAS float* s = scr + (8 * c) * 33 + n;
        v4u o; o.x = pk2(s[0 * 33], s[1 * 33]); o.y = pk2(s[2 * 33], s[3 * 33]); o.z = pk2(s[4 * 33], s[5 * 33]); o.w = pk2(s[6 * 33], s[7 * 33]);
        *(v4u*)(WT + (size_t)(n0 + n) * K + k0 + 8 * c) = o; }
    LDS_WAIT(); asm volatile("" ::: "memory");
}
__device__ __forceinline__ void p0_wq(Frame& F, int task) {
    const int hh = task >> 4, d0 = 64 * (task & 15), h = hh >> 1, half = hh & 1, tid = F.tid;
    LAS float* keys = (LAS float*)F.lds;
    LAS float* wq = keys + 128 * 128;
    const float* kp = (half ? F.sub_keys2 : F.sub_keys1) + (size_t)h * 128 * 128;
    for (int i = tid; i < 4096; i += NT) ((LAS f32x4*)keys)[i] = ((const f32x4*)kp)[i];
    for (int i = tid; i < 64 * 32; i += NT) { const int r = i >> 5, c4 = i & 31; *(LAS f32x4*)(wq + r * 132 + 4 * c4) = *(const f32x4*)(F.w_query + (size_t)(d0 + r) * 2048 + hh * 128 + 4 * c4); }
    __syncthreads();
    const int d = tid & 63, kg = tid >> 6;
    float acc[16];
#pragma unroll
    for (int k = 0; k < 16; ++k) acc[k] = 0.f;
    for (int j4 = 0; j4 < 32; ++j4) { const f32x4 w = *(LAS f32x4*)(wq + d * 132 + 4 * j4);
#pragma unroll
        for (int k = 0; k < 16; ++k) { const f32x4 kv = *(LAS f32x4*)(keys + (16 * kg + k) * 128 + 4 * j4); acc[k] += (kv.x * w.x + kv.y * w.y) + (kv.z * w.z + kv.w * w.w); } }
    bf16* WQ = WSP(bf16, WS_WQ);
#pragma unroll
    for (int k = 0; k < 16; ++k) WQ[(size_t)(hh * 128 + 16 * kg + k) * 1024 + d0 + d] = (bf16)f2bf(acc[k]);
    __syncthreads();
}
__device__ __forceinline__ void p0_cond(Frame& F, int task) {
    const int tid = F.tid;
    LAS float* sc = (LAS float*)F.lds;
    LAS float* red = sc + 4096;
    for (int i = tid; i < 4096; i += NT) sc[i] = silu_f(F.c[i]);
    __syncthreads();
    const int l8 = tid & 7, rs = tid >> 3;
    const float* wp = F.w_cond + (size_t)rs * 6144 + 32 * task + 4 * l8;
    f32x4 w[16];
#pragma unroll
    for (int i = 0; i < 16; ++i) w[i] = *(const f32x4*)(wp + (size_t)i * 64 * 6144);
    f32x4 acc[4];
#pragma unroll
    for (int b = 0; b < 4; ++b) acc[b] = (f32x4){0.f, 0.f, 0.f, 0.f};
#pragma unroll
    for (int i = 0; i < 16; ++i)
#pragma unroll
        for (int b = 0; b < 4; ++b) acc[b] += w[i] * sc[b * 1024 + 64 * i + rs];
#pragma unroll
    for (int b = 0; b < 4; ++b)
#pragma unroll
        for (int e = 0; e < 4; ++e) { float v = acc[b][e]; v += __shfl_xor(v, 8); v += __shfl_xor(v, 16); v += __shfl_xor(v, 32); if ((F.lane >> 3) == 0) red[(F.wave * 8 + l8) * 16 + b * 4 + e] = v; }
    __syncthreads();
    if (tid < 128) { const int b = tid >> 5, col = tid & 31, q8 = col >> 2, e = col & 3; float s = 0.f;
#pragma unroll
        for (int wv = 0; wv < 8; ++wv) s += red[(wv * 8 + q8) * 16 + b * 4 + e];
        WSP(float, WS_COND)[b * 6144 + 32 * task + col] = s + F.b_cond[32 * task + col]; }
    __syncthreads();
}
__device__ __forceinline__ void p0_prologue(Frame& F) {
    for (int task = F.bid; task < 256; task += F.G) p0_wq(F, task);
    for (int task = F.bid; task < 192; task += F.G) p0_cond(F, task);
    LAS float* scr = (LAS float*)(F.lds + F.wave * 16384);
    const int gw = F.bid * NWAVES + F.wave, NGW = F.G * NWAVES;
    constexpr int I_IN = (D / 64) * (N1 / 32), I_OUT = (2048 / 64) * (1024 / 32);
    for (int it = gw; it < I_IN + I_OUT; it += NGW) {
        if (it < I_IN) p0_transpose_item(F.w_in, INW, D, N1, WSP(bf16, WS_WIN), scr, it, F.lane);
        else p0_transpose_item(F.w_out, 1024, 2048, 1024, WSP(bf16, WS_WOUT), scr, it - I_IN, F.lane);
    }
}

__device__ __forceinline__ void p1_modulate(Frame& F, bf16* U1) {
    LAS float* wdt = (LAS float*)F.lds;
    for (int i = F.tid; i < 16384; i += NT) { const int d = i >> 4, h = i & 15; wdt[h * 1024 + d] = F.w_in[(size_t)d * INW + C_DT + h]; }
    __syncthreads();
    const int gw = F.bid * NWAVES + F.wave, NGW = F.G * NWAVES, lane = F.lane;
    const float* COND = WSP(float, WS_COND); float* DT = WSP(float, WS_DT);
    for (int m = gw; m < T; m += NGW) {
        const int b = m >> 12; const float* cd = COND + b * 6144;
        const f32x4* xr = (const f32x4*)(F.x + (size_t)m * D) + lane;
        float part[16];
#pragma unroll
        for (int h = 0; h < 16; ++h) part[h] = 0.f;
#pragma unroll 1
        for (int j = 0; j < 4; ++j) { const int col = 4 * lane + 256 * j; const f32x4 v = xr[64 * j], sh = *(const f32x4*)(cd + col), scl = *(const f32x4*)(cd + 1024 + col);
            const f32x4 u = v * (scl + 1.0f) + sh;
            v2u o; o.x = pk2(u.x, u.y); o.y = pk2(u.z, u.w); *(v2u*)(U1 + (size_t)m * D + col) = o;
#pragma unroll
            for (int h = 0; h < 16; ++h) { const f32x4 w = *(LAS f32x4*)(wdt + h * 1024 + col); part[h] += (u.x * w.x + u.y * w.y) + (u.z * w.z + u.w * w.w); } }
        float mine = 0.f;
#pragma unroll
        for (int h = 0; h < 16; ++h) { const float s = wave_sum(part[h]); mine = (lane == h) ? s : mine; }
        if (lane < 16) { const float v = mine + F.dt_bias[lane]; DT[(size_t)m * 16 + lane] = v > 20.f ? v : log1pf(__expf(v)); }
    }
}

constexpr int RS = 272;
__device__ __forceinline__ void p3_unit(Frame& F, int unit, bf16* ST) {
    const int g = unit & 1, bc = unit >> 1, b = bc >> 5, c = bc & 31, t0 = b * SEQ + c * LCH, tid = F.tid, lane = F.lane, wave = F.wave;
    const int r = lane & 15, q = lane >> 4;
    LAS unsigned char* BT = F.lds;
    LAS unsigned char* R1 = F.lds + 34816;
    LAS unsigned char* Bnat = R1; LAS unsigned char* Cnat = R1 + 34816; LAS unsigned char* xwT = R1;
    LAS float* acum_s = (LAS float*)(F.lds + 104448);
    LAS float* wts = acum_s + 1024;
    const bf16* PROJ = WSP(bf16, WS_PROJ); const float* DT = WSP(const float, WS_DT); float* ACUM = WSP(float, WS_ACUM);
    {
        const int h = 8 * g + wave; const float a = -__expf(F.a_log[h]);
        const float d0 = DT[(size_t)(t0 + 2 * lane) * 16 + h], d1 = DT[(size_t)(t0 + 2 * lane + 1) * 16 + h];
        const float v0 = a * d0, v1 = a * d1; float s = v0 + v1;
#pragma unroll
        for (int o = 1; o < 64; o <<= 1) { const float t = __shfl_up(s, o); if (lane >= o) s += t; }
        float ex = __shfl_up(s, 1); if (lane == 0) ex = 0.f;
        const float c0 = ex + v0, c1 = c0 + v1, end = __shfl(s, 63);
        acum_s[wave * 128 + 2 * lane] = c0; acum_s[wave * 128 + 2 * lane + 1] = c1;
        wts[wave * 128 + 2 * lane] = d0 * __expf(end - c0); wts[wave * 128 + 2 * lane + 1] = d1 * __expf(end - c1);
        ACUM[(size_t)(t0 + 2 * lane) * 16 + h] = c0; ACUM[(size_t)(t0 + 2 * lane + 1) * 16 + h] = c1;
    }
    {
        const int ch = tid & 255, lh = tid >> 8, isC = ch >> 7, n = ch & 127;
        const int col = C_B + isC * 256 + 128 * g + n, cw = 1024 + isC * 256 + 128 * g + n;
        const float w0 = F.ssm_conv_w[cw], w1 = F.ssm_conv_w[1536 + cw], w2 = F.ssm_conv_w[2 * 1536 + cw], w3 = F.ssm_conv_w[3 * 1536 + cw], bias = F.ssm_conv_b[cw];
        const bf16* p = PROJ + (size_t)(t0 + 64 * lh) * N1 + col;
        float h0 = 0.f, h1 = 0.f, h2 = 0.f;
        if (!(c == 0 && lh == 0)) { h0 = bf1(p[-3 * N1]); h1 = bf1(p[-2 * N1]); h2 = bf1(p[-1 * N1]); }
        bf16* CN = WSP(bf16, WS_CN);
        for (int st = 0; st < 8; ++st) {
            float raw[8]; unsigned ob[8];
#pragma unroll
            for (int i = 0; i < 8; ++i) raw[i] = bf1(p[(size_t)(st * 8 + i) * N1]);
#pragma unroll
            for (int i = 0; i < 8; ++i) { const float v = w0 * h0 + w1 * h1 + w2 * h2 + w3 * raw[i] + bias; h0 = h1; h1 = h2; h2 = raw[i]; ob[i] = f2bf(silu_f(v)); }
            const int l = 64 * lh + 8 * st;
            if (!isC) {
                v4u pk; pk.x = ob[0] | (ob[1] << 16); pk.y = ob[2] | (ob[3] << 16); pk.z = ob[4] | (ob[5] << 16); pk.w = ob[6] | (ob[7] << 16);
                *(LAS v4u*)(BT + n * RS + l * 2) = pk;
#pragma unroll
                for (int i = 0; i < 8; ++i) *(LAS bf16*)(Bnat + (l + i) * RS + n * 2) = (bf16)ob[i];
            } else {
#pragma unroll
                for (int i = 0; i < 8; ++i) { *(LAS bf16*)(Cnat + (l + i) * RS + n * 2) = (bf16)ob[i]; CN[(size_t)(t0 + l + i) * 256 + 128 * g + n] = (bf16)ob[i]; }
            }
        }
    }
    __syncthreads();
    {
        const int l0 = 16 * wave; bf16x8 cf[4];
#pragma unroll
        for (int ks = 0; ks < 4; ++ks) cf[ks] = *(LAS bf16x8*)(Cnat + (l0 + r) * RS + (32 * ks + 8 * q) * 2);
        bf16* CBG = WSP(bf16, WS_CB) + (size_t)unit * 16384;
#pragma unroll
        for (int st = 0; st < 8; ++st) { f32x4 acc = (f32x4){0.f, 0.f, 0.f, 0.f};
#pragma unroll
            for (int ks = 0; ks < 4; ++ks) { const bf16x8 af = *(LAS bf16x8*)(Bnat + (16 * st + r) * RS + (32 * ks + 8 * q) * 2); acc = mfma16(af, cf[ks], acc); }
            v2u o; o.x = pk2(acc[0], acc[1]); o.y = pk2(acc[2], acc[3]);
            *(v2u*)(CBG + (l0 + r) * 128 + 16 * st + 4 * q) = o; }
    }
    __syncthreads();
    bf16* XT = WSP(bf16, WS_XT);
    for (int rd = 0; rd < 2; ++rd) {
        {
            const int ch = tid & 255, lh = tid >> 8, hl = 4 * rd + (ch >> 6), p_ = ch & 63, head = 8 * g + hl;
            const int col = C_X + 512 * g + 256 * rd + ch, cw = 512 * g + 256 * rd + ch;
            const float w0 = F.ssm_conv_w[cw], w1 = F.ssm_conv_w[1536 + cw], w2 = F.ssm_conv_w[2 * 1536 + cw], w3 = F.ssm_conv_w[3 * 1536 + cw], bias = F.ssm_conv_b[cw];
            const bf16* p = PROJ + (size_t)(t0 + 64 * lh) * N1 + col;
            float h0 = 0.f, h1 = 0.f, h2 = 0.f;
            if (!(c == 0 && lh == 0)) { h0 = bf1(p[-3 * N1]); h1 = bf1(p[-2 * N1]); h2 = bf1(p[-1 * N1]); }
            bf16* xtg = XT + ((size_t)(bc * 16 + head) * 64 + p_) * 128;
            for (int st = 0; st < 8; ++st) {
                float raw[8], ov[8];
#pragma unroll
                for (int i = 0; i < 8; ++i) raw[i] = bf1(p[(size_t)(st * 8 + i) * N1]);
#pragma unroll
                for (int i = 0; i < 8; ++i) { const float v = w0 * h0 + w1 * h1 + w2 * h2 + w3 * raw[i] + bias; h0 = h1; h1 = h2; h2 = raw[i]; ov[i] = silu_f(v); }
                const int l = 64 * lh + 8 * st;
                v4u pk; pk.x = pk2(ov[0], ov[1]); pk.y = pk2(ov[2], ov[3]); pk.z = pk2(ov[4], ov[5]); pk.w = pk2(ov[6], ov[7]);
                *(v4u*)(xtg + l) = pk;
                const f32x4 wa = *(LAS f32x4*)(wts + hl * 128 + l), wb = *(LAS f32x4*)(wts + hl * 128 + l + 4);
                v4u pw; pw.x = pk2(ov[0] * wa.x, ov[1] * wa.y); pw.y = pk2(ov[2] * wa.z, ov[3] * wa.w); pw.z = pk2(ov[4] * wb.x, ov[5] * wb.y); pw.w = pk2(ov[6] * wb.z, ov[7] * wb.w);
                *(LAS v4u*)(xwT + ch * RS + l * 2) = pw;
            }
        }
        __syncthreads();
        {
            const int hl2 = wave >> 1, nh = wave & 1, head = 8 * g + 4 * rd + hl2;
            f32x4 acc[4][4];
#pragma unroll
            for (int a = 0; a < 4; ++a)
#pragma unroll
                for (int b2 = 0; b2 < 4; ++b2) acc[a][b2] = (f32x4){0.f, 0.f, 0.f, 0.f};
#pragma unroll
            for (int ks = 0; ks < 4; ++ks) { bf16x8 af[4], bfr[4];
#pragma unroll
                for (int nt = 0; nt < 4; ++nt) af[nt] = *(LAS bf16x8*)(BT + (64 * nh + 16 * nt + r) * RS + (32 * ks + 8 * q) * 2);
#pragma unroll
                for (int pt = 0; pt < 4; ++pt) bfr[pt] = *(LAS bf16x8*)(xwT + (64 * hl2 + 16 * pt + r) * RS + (32 * ks + 8 * q) * 2);
#pragma unroll
                for (int nt = 0; nt < 4; ++nt)
#pragma unroll
                    for (int pt = 0; pt < 4; ++pt) acc[nt][pt] = mfma16(af[nt], bfr[pt], acc[nt][pt]); }
            bf16* stg = ST + (size_t)(bc * 16 + head) * 8192;
#pragma unroll
            for (int nt = 0; nt < 4; ++nt)
#pragma unroll
                for (int pt = 0; pt < 4; ++pt) { v2u o; o.x = pk2(acc[nt][pt][0], acc[nt][pt][1]); o.y = pk2(acc[nt][pt][2], acc[nt][pt][3]);
                    *(v2u*)(stg + (16 * pt + r) * 128 + 64 * nh + 16 * nt + 4 * q) = o; }
        }
        __syncthreads();
    }
    {
        const int cg = tid & 63, rs = tid >> 6, ch0 = 512 * g + 8 * cg;
        float w0[8], w1[8], w2[8], nw[8], pm2[8], pm1[8];
#pragma unroll
        for (int e = 0; e < 8; ++e) { w0[e] = F.sc_conv_w[ch0 + e]; w1[e] = F.sc_conv_w[1024 + ch0 + e]; w2[e] = F.sc_conv_w[2048 + ch0 + e]; nw[e] = F.sc_norm_w[ch0 + e]; pm2[e] = 0.f; pm1[e] = 0.f; }
        bf16* P = WSP(bf16, WS_PROJ) + (size_t)(t0 + 16 * rs) * N1 + ch0;
        if (!(c == 0 && rs == 0)) {
            const v4u c2 = *(const v4u*)(P - 2 * N1 + C_SCC), hh2 = *(const v4u*)(P - 2 * N1 + C_SCH), c1 = *(const v4u*)(P - N1 + C_SCC), hh1 = *(const v4u*)(P - N1 + C_SCH);
            pm2[0] = bflo(c2.x) * bflo(hh2.x); pm2[1] = bfhi(c2.x) * bfhi(hh2.x); pm2[2] = bflo(c2.y) * bflo(hh2.y); pm2[3] = bfhi(c2.y) * bfhi(hh2.y);
            pm2[4] = bflo(c2.z) * bflo(hh2.z); pm2[5] = bfhi(c2.z) * bfhi(hh2.z); pm2[6] = bflo(c2.w) * bflo(hh2.w); pm2[7] = bfhi(c2.w) * bfhi(hh2.w);
            pm1[0] = bflo(c1.x) * bflo(hh1.x); pm1[1] = bfhi(c1.x) * bfhi(hh1.x); pm1[2] = bflo(c1.y) * bflo(hh1.y); pm1[3] = bfhi(c1.y) * bfhi(hh1.y);
            pm1[4] = bflo(c1.z) * bflo(hh1.z); pm1[5] = bfhi(c1.z) * bfhi(hh1.z); pm1[6] = bflo(c1.w) * bflo(hh1.w); pm1[7] = bfhi(c1.w) * bfhi(hh1.w);
        }
        for (int i = 0; i < 16; ++i) {
            bf16* row = P + (size_t)i * N1;
            const v4u bv = *(const v4u*)(row + C_SCB), cv = *(const v4u*)(row + C_SCC), hv = *(const v4u*)(row + C_SCH);
            float pr[8], bb[8], y[8];
            pr[0] = bflo(cv.x) * bflo(hv.x); pr[1] = bfhi(cv.x) * bfhi(hv.x); pr[2] = bflo(cv.y) * bflo(hv.y); pr[3] = bfhi(cv.y) * bfhi(hv.y);
            pr[4] = bflo(cv.z) * bflo(hv.z); pr[5] = bfhi(cv.z) * bfhi(hv.z); pr[6] = bflo(cv.w) * bflo(hv.w); pr[7] = bfhi(cv.w) * bfhi(hv.w);
            bb[0] = bflo(bv.x); bb[1] = bfhi(bv.x); bb[2] = bflo(bv.y); bb[3] = bfhi(bv.y); bb[4] = bflo(bv.z); bb[5] = bfhi(bv.z); bb[6] = bflo(bv.w); bb[7] = bfhi(bv.w);
            float ss = 0.f;
#pragma unroll
            for (int e = 0; e < 8; ++e) { y[e] = (w0[e] * pm2[e] + w1[e] * pm1[e] + w2[e] * pr[e]) * bb[e]; ss += y[e] * y[e]; pm2[e] = pm1[e]; pm1[e] = pr[e]; }
            ss += __shfl_xor(ss, 1); ss += __shfl_xor(ss, 2); ss += __shfl_xor(ss, 4);
            const float rstd = rsqrtf(ss * (1.0f / 64.0f) + RMS_EPS);
            v4u o; o.x = pk2(y[0] * rstd * nw[0], y[1] * rstd * nw[1]); o.y = pk2(y[2] * rstd * nw[2], y[3] * rstd * nw[3]);
            o.z = pk2(y[4] * rstd * nw[4], y[5] * rstd * nw[5]); o.w = pk2(y[6] * rstd * nw[6], y[7] * rstd * nw[7]);
            *(v4u*)(row + C_SCB) = o;
        }
    }
    __syncthreads();
}

__device__ __forceinline__ void p4_scan(Frame& F, bf16* ST) {
    const float* ACUM = WSP(const float, WS_ACUM);
    for (int e = F.bid * NT + F.tid; e < NB * 16 * 2048; e += F.G * NT) {
        const int b = e >> 15, h = (e >> 11) & 15, pn4 = e & 2047;
        bf16* base = ST + ((size_t)(b * NCH) * 16 + h) * 8192 + pn4 * 4;
        float run[4] = {0.f, 0.f, 0.f, 0.f};
        for (int c0 = 0; c0 < NCH; c0 += 8) {
            v2u s[8]; float dec[8];
#pragma unroll
            for (int k = 0; k < 8; ++k) { s[k] = *(const v2u*)(base + (size_t)(c0 + k) * 131072); dec[k] = ACUM[(size_t)(b * SEQ + (c0 + k) * LCH + 127) * 16 + h]; }
#pragma unroll
            for (int k = 0; k < 8; ++k) { const float d = __expf(dec[k]);
                v2u o; o.x = pk2(run[0], run[1]); o.y = pk2(run[2], run[3]); *(v2u*)(base + (size_t)(c0 + k) * 131072) = o;
                run[0] = run[0] * d + bflo(s[k].x); run[1] = run[1] * d + bfhi(s[k].x); run[2] = run[2] * d + bflo(s[k].y); run[3] = run[3] * d + bfhi(s[k].y); }
        }
    }
}

__device__ __forceinline__ void p5_unit(Frame& F, int unit, const bf16* ST) {
    const int g = unit & 1, bc = unit >> 1, b = bc >> 5, c = bc & 31, t0 = b * SEQ + c * LCH, tid = F.tid, lane = F.lane, wave = F.wave;
    const int r = lane & 15, q = lane >> 4, l = 16 * wave + r;
    LAS unsigned char* buf0 = F.lds; LAS unsigned char* buf1 = F.lds + 34816;
    LAS float* acum_s = (LAS float*)(F.lds + 69632);
    LAS float* dt_s = acum_s + 1024;
    const float* DT = WSP(const float, WS_DT); const float* ACUM = WSP(const float, WS_ACUM);
    const bf16* XT = WSP(const bf16, WS_XT); bf16* PROJ = WSP(bf16, WS_PROJ);
    for (int i = tid; i < 1024; i += NT) { const int hl = i >> 7, s = i & 127; acum_s[i] = ACUM[(size_t)(t0 + s) * 16 + 8 * g + hl]; dt_s[i] = DT[(size_t)(t0 + s) * 16 + 8 * g + hl]; }
    v4u cbf[4], cf[4];
    {
        const bf16* CBG = WSP(const bf16, WS_CB) + (size_t)unit * 16384; const bf16* CN = WSP(const bf16, WS_CN);
#pragma unroll
        for (int ks = 0; ks < 4; ++ks) { cbf[ks] = *(const v4u*)(CBG + l * 128 + 32 * ks + 8 * q); cf[ks] = *(const v4u*)(CN + (size_t)(t0 + l) * 256 + 128 * g + 32 * ks + 8 * q); }
    }
    v4u sx[2], sp[2];
    const int ci0 = tid, ci1 = tid + 512;
    const int lo0 = (ci0 >> 4) * RS + (ci0 & 15) * 16, lo1 = (ci1 >> 4) * RS + (ci1 & 15) * 16;
#define P5_LOAD(hd) do { const size_t o_ = (size_t)(bc * 16 + (hd)) * 8192; sx[0] = *(const v4u*)(XT + o_ + ci0 * 8); sx[1] = *(const v4u*)(XT + o_ + ci1 * 8); \
        sp[0] = *(const v4u*)(ST + o_ + ci0 * 8); sp[1] = *(const v4u*)(ST + o_ + ci1 * 8); } while (0)
#define P5_WRITE(bufp) do { *(LAS v4u*)((bufp) + lo0) = sx[0]; *(LAS v4u*)((bufp) + lo1) = sx[1]; *(LAS v4u*)((bufp) + 17408 + lo0) = sp[0]; *(LAS v4u*)((bufp) + 17408 + lo1) = sp[1]; } while (0)
    P5_LOAD(8 * g); P5_WRITE(buf0);
    __syncthreads();
    float sumsq = 0.f;
    bf16* zrow = PROJ + (size_t)(t0 + l) * N1 + C_Z + 512 * g;
#pragma unroll 1
    for (int hl = 0; hl < 8; ++hl) {
        const int head = 8 * g + hl; LAS unsigned char* cur = (hl & 1) ? buf1 : buf0; LAS unsigned char* nxtb = (hl & 1) ? buf0 : buf1;
        if (hl < 7) P5_LOAD(head + 1);
        const float acl = acum_s[hl * 128 + l];
        bf16x8 mf[4];
#pragma unroll
        for (int ks = 0; ks < 4; ++ks) { const int s0 = 32 * ks + 8 * q;
            const f32x4 a0 = *(LAS f32x4*)(acum_s + hl * 128 + s0), a1 = *(LAS f32x4*)(acum_s + hl * 128 + s0 + 4), e0 = *(LAS f32x4*)(dt_s + hl * 128 + s0), e1 = *(LAS f32x4*)(dt_s + hl * 128 + s0 + 4);
            const float as[8] = {a0.x, a0.y, a0.z, a0.w, a1.x, a1.y, a1.z, a1.w}, ds[8] = {e0.x, e0.y, e0.z, e0.w, e1.x, e1.y, e1.z, e1.w};
            const unsigned cw[4] = {cbf[ks].x, cbf[ks].y, cbf[ks].z, cbf[ks].w}; float m[8];
#pragma unroll
            for (int j = 0; j < 8; ++j) { const float cbv = (j & 1) ? bfhi(cw[j >> 1]) : bflo(cw[j >> 1]); const bool ok = (s0 + j) <= l; const float seg = ok ? (acl - as[j]) : 0.f; m[j] = ok ? cbv * __expf(seg) * ds[j] : 0.f; }
            v4u pk; pk.x = pk2(m[0], m[1]); pk.y = pk2(m[2], m[3]); pk.z = pk2(m[4], m[5]); pk.w = pk2(m[6], m[7]); mf[ks] = __builtin_bit_cast(bf16x8, pk); }
        f32x4 d1[4], d2[4];
#pragma unroll
        for (int pt = 0; pt < 4; ++pt) { d1[pt] = (f32x4){0.f, 0.f, 0.f, 0.f}; d2[pt] = (f32x4){0.f, 0.f, 0.f, 0.f}; }
#pragma unroll
        for (int ks = 0; ks < 4; ++ks) {
            if (32 * ks <= 16 * wave + 15) {
#pragma unroll
                for (int pt = 0; pt < 4; ++pt) { const bf16x8 af = *(LAS bf16x8*)(cur + (16 * pt + r) * RS + (32 * ks + 8 * q) * 2); d1[pt] = mfma16(af, mf[ks], d1[pt]); } }
#pragma unroll
            for (int pt = 0; pt < 4; ++pt) { const bf16x8 af = *(LAS bf16x8*)(cur + 17408 + (16 * pt + r) * RS + (32 * ks + 8 * q) * 2); d2[pt] = mfma16(af, __builtin_bit_cast(bf16x8, cf[ks]), d2[pt]); }
        }
        const float dfs = __expf(acl), dsk = F.d_skip[head];
#pragma unroll
        for (int pt = 0; pt < 4; ++pt) { const int p0 = 16 * pt + 4 * q;
            const v2u zv = *(const v2u*)(zrow + 64 * hl + p0); const float zf[4] = {bflo(zv.x), bfhi(zv.x), bflo(zv.y), bfhi(zv.y)}; float y[4];
#pragma unroll
            for (int e = 0; e < 4; ++e) { const float xv = bf1(*(LAS bf16*)(cur + (p0 + e) * RS + l * 2)); float v = d1[pt][e] + dfs * d2[pt][e] + dsk * xv; v *= silu_f(zf[e]); sumsq += v * v; y[e] = v; }
            v2u yo; yo.x = pk2(y[0], y[1]); yo.y = pk2(y[2], y[3]); *(v2u*)(zrow + 64 * hl + p0) = yo; }
        if (hl < 7) P5_WRITE(nxtb);
        __syncthreads();
    }
#undef P5_LOAD
#undef P5_WRITE
    sumsq += __shfl_xor(sumsq, 16); sumsq += __shfl_xor(sumsq, 32);
    const float rstd = rsqrtf(sumsq * (1.0f / 512.0f) + RMS_EPS);
    asm volatile("s_waitcnt vmcnt(0)" ::: "memory");
#pragma unroll 2
    for (int hl = 0; hl < 8; ++hl)
#pragma unroll
        for (int pt = 0; pt < 4; ++pt) { const int p0 = 16 * pt + 4 * q; const f32x4 nw = *(const f32x4*)(F.ssm_norm_w + 512 * g + 64 * hl + p0);
            const v2u yv = *(const v2u*)(zrow + 64 * hl + p0);
            v2u o; o.x = pk2(bflo(yv.x) * rstd * nw.x, bfhi(yv.x) * rstd * nw.y); o.y = pk2(bflo(yv.y) * rstd * nw.z, bfhi(yv.y) * rstd * nw.w);
            *(v2u*)(zrow + 64 * hl + p0) = o; }
    __syncthreads();
}

__device__ __forceinline__ void p7_ln1(Frame& F, const float* PRE) {
    const int gw = F.bid * NWAVES + F.wave, NGW = F.G * NWAVES, lane = F.lane;
    const float* COND = WSP(const float, WS_COND); float* X1 = WSP(float, WS_X1); bf16* U2 = WSP(bf16, WS_U2);
    for (int m = gw; m < T; m += NGW) {
        const int b = m >> 12; const float* cd = COND + b * 6144;
        const f32x4* xr = (const f32x4*)(PRE + (size_t)m * D) + lane;
        f32x4 v[4]; float s = 0.f;
#pragma unroll
        for (int j = 0; j < 4; ++j) { v[j] = xr[64 * j]; s += (v[j].x + v[j].y) + (v[j].z + v[j].w); }
        const float mean = wave_sum(s) * (1.f / D); float s2 = 0.f;
#pragma unroll
        for (int j = 0; j < 4; ++j) { v[j] = v[j] - mean; s2 += (v[j].x * v[j].x + v[j].y * v[j].y) + (v[j].z * v[j].z + v[j].w * v[j].w); }
        const float rstd = rsqrtf(wave_sum(s2) * (1.f / D) + LN_EPS);
#pragma unroll
        for (int j = 0; j < 4; ++j) { const int col = 4 * lane + 256 * j;
            const f32x4 gg = *(const f32x4*)(F.ln1_g + col), bb = *(const f32x4*)(F.ln1_b + col), sh = *(const f32x4*)(cd + 3 * 1024 + col), scl = *(const f32x4*)(cd + 4 * 1024 + col);
            const f32x4 x1 = v[j] * rstd * gg + bb; *(f32x4*)(X1 + (size_t)m * D + col) = x1;
            const f32x4 u = x1 * (scl + 1.0f) + sh; v2u o; o.x = pk2(u.x, u.y); o.y = pk2(u.z, u.w); *(v2u*)(U2 + (size_t)m * D + col) = o; }
    }
    const size_t NQ = (size_t)16384 * 1024 / 4;
    v2u* EU = WSP(v2u, WS_EU); v2u* EV = WSP(v2u, WS_EV);
    const f32x4* su = (const f32x4*)F.expert_u; const f32x4* sv = (const f32x4*)F.expert_v;
    const size_t stride = (size_t)F.G * NT;
    for (size_t i = (size_t)F.bid * NT + F.tid; i < NQ; i += 4 * stride) {
        f32x4 a[4], bq[4];
#pragma unroll
        for (int k = 0; k < 4; ++k) { const size_t ii = i + k * stride; if (ii < NQ) { a[k] = su[ii]; bq[k] = sv[ii]; } }
#pragma unroll
        for (int k = 0; k < 4; ++k) { const size_t ii = i + k * stride; if (ii < NQ) { v2u o; o.x = pk2(a[k].x, a[k].y); o.y = pk2(a[k].z, a[k].w); EU[ii] = o; v2u o2; o2.x = pk2(bq[k].x, bq[k].y); o2.y = pk2(bq[k].z, bq[k].w); EV[ii] = o2; } }
    }
}

__device__ __forceinline__ int med3i(int a, int b, int c) { int d; asm("v_med3_i32 %0, %1, %2, %3" : "=v"(d) : "v"(a), "v"(b), "v"(c)); return d; }
__device__ __forceinline__ int ord_key(unsigned bits) { const int s = (int)bits; return s ^ ((s >> 31) & 0x7fffffff); }
#define TOPK_INSERT(L, k) do { _Pragma("unroll") for (int j_ = 15; j_ >= 1; --j_) L[j_] = med3i(L[j_ - 1], L[j_], (k)); L[0] = max(L[0], (k)); } while (0)
__device__ __forceinline__ float gelu_exact(float v) { return 0.5f * v * (1.0f + erff(v * 0.70710678118654752f)); }

__device__ __forceinline__ void p9_topk(Frame& F, int tb) {
    const int lane = F.lane, wave = F.wave;
    LAS unsigned char* idxs = F.lds;
    const bf16* SC = WSP(const bf16, WS_SC);
    unsigned short* EIDX = WSP(unsigned short, WS_EIDX); float* GATE = WSP(float, WS_GATE);
    int L1[16], L2[16];
#pragma unroll
    for (int j = 0; j < 16; ++j) { L1[j] = (int)0x80000000; L2[j] = (int)0x80000000; }
    const bf16* s1p = SC + ((((size_t)tb * 16 + 2 * wave) * 16) * 64 + lane) * 8;
    const bf16* s2p = s1p + (size_t)16 * 64 * 8;
    for (int kc = 0; kc < 16; kc += 4) {
        v4u a[4], bq[4];
#pragma unroll
        for (int u = 0; u < 4; ++u) { a[u] = *(const v4u*)(s1p + (size_t)(kc + u) * 512); bq[u] = *(const v4u*)(s2p + (size_t)(kc + u) * 512); }
#pragma unroll
        for (int u = 0; u < 4; ++u) {
            const unsigned wa[4] = {a[u].x, a[u].y, a[u].z, a[u].w}, wb[4] = {bq[u].x, bq[u].y, bq[u].z, bq[u].w};
#pragma unroll
            for (int e = 0; e < 8; ++e) { const int idx = 8 * (kc + u) + e;
                const unsigned b1 = (e & 1) ? (wa[e >> 1] & 0xffff0000u) : (wa[e >> 1] << 16), b2 = (e & 1) ? (wb[e >> 1] & 0xffff0000u) : (wb[e >> 1] << 16);
                const int k1 = (ord_key(b1) & ~127) | (127 - idx), k2 = (ord_key(b2) & ~127) | (127 - idx);
                TOPK_INSERT(L1, k1); TOPK_INSERT(L2, k2); }
        }
    }
    float v1[16], v2[16]; unsigned ib[8];
#pragma unroll
    for (int j = 0; j < 8; ++j) ib[j] = 0u;
#pragma unroll
    for (int j = 0; j < 16; ++j) { v1[j] = __builtin_bit_cast(float, (unsigned)ord_key((unsigned)L1[j]) & 0xffff0000u); v2[j] = __builtin_bit_cast(float, (unsigned)ord_key((unsigned)L2[j]) & 0xffff0000u);
        ib[j >> 2] |= (unsigned)(127 - (L1[j] & 127)) << (8 * (j & 3)); ib[4 + (j >> 2)] |= (unsigned)(127 - (L2[j] & 127)) << (8 * (j & 3)); }
    LAS unsigned char* myidx = idxs + (wave * 64 + lane) * 32;
    { v4u o0, o1; o0.x = ib[0]; o0.y = ib[1]; o0.z = ib[2]; o0.w = ib[3]; o1.x = ib[4]; o1.y = ib[5]; o1.z = ib[6]; o1.w = ib[7]; *(LAS v4u*)myidx = o0; *(LAS v4u*)(myidx + 16) = o1; }
    int Fk[16];
#pragma unroll
    for (int j = 0; j < 16; ++j) Fk[j] = (int)0x80000000;
#pragma unroll
    for (int a = 0; a < 16; ++a)
#pragma unroll
        for (int b2 = 0; b2 < 16; ++b2)
            if ((a + 1) * (b2 + 1) <= 16) { const float sm = v1[a] + v2[b2]; const int k = (ord_key(__builtin_bit_cast(unsigned, sm)) & ~255) | (255 - (a * 16 + b2)); TOPK_INSERT(Fk, k); }
    LDS_WAIT(); asm volatile("" ::: "memory");
    float sv[16], ssum = 0.f;
#pragma unroll
    for (int j = 0; j < 16; ++j) sv[j] = __builtin_bit_cast(float, (unsigned)ord_key((unsigned)Fk[j]));
    const float smax = sv[0];
#pragma unroll
    for (int j = 0; j < 16; ++j) { sv[j] = __expf(sv[j] - smax); ssum += sv[j]; }
    const float inv = 1.0f / ssum;
    const int t = tb * 64 + lane;
    unsigned ew[8];
#pragma unroll
    for (int j = 0; j < 16; ++j) { const int ab = 255 - (Fk[j] & 255); const int i1 = myidx[ab >> 4], i2 = myidx[16 + (ab & 15)]; const unsigned e = (unsigned)(i1 * 128 + i2);
        if (j & 1) ew[j >> 1] |= e << 16; else ew[j >> 1] = e; sv[j] *= inv; }
    { v4u o0, o1; o0.x = ew[0]; o0.y = ew[1]; o0.z = ew[2]; o0.w = ew[3]; o1.x = ew[4]; o1.y = ew[5]; o1.z = ew[6]; o1.w = ew[7];
      *(v4u*)(EIDX + (size_t)t * 128 + wave * 16) = o0; *(v4u*)(EIDX + (size_t)t * 128 + wave * 16 + 8) = o1; }
#pragma unroll
    for (int j4 = 0; j4 < 4; ++j4) *(f32x4*)(GATE + (size_t)t * 128 + wave * 16 + 4 * j4) = (f32x4){sv[4 * j4], sv[4 * j4 + 1], sv[4 * j4 + 2], sv[4 * j4 + 3]};
    LDS_WAIT(); __syncthreads();
}

__device__ __forceinline__ void p10_u(Frame& F) {
    const int lane = F.lane, wave = F.wave, q = lane >> 4, j16 = lane & 15;
    LAS unsigned* plist = (LAS unsigned*)(F.lds + wave * 1024);
    const bf16* U2 = WSP(const bf16, WS_U2); const bf16* EU = WSP(const bf16, WS_EU);
    const unsigned* EIDX2 = WSP(const unsigned, WS_EIDX); float* GATE = WSP(float, WS_GATE);
    const int xg = F.bid & 7, rk = F.bid >> 3, nrk = (F.G + 7 - xg) / 8 > 0 ? (F.G - xg + 7) / 8 : 1;
    for (int pass = 0; pass < 2; ++pass) {
        const unsigned slice = (unsigned)(xg + 8 * pass);
        for (int t = rk * NWAVES + wave; t < T; t += nrk * NWAVES) {
            const unsigned ee = EIDX2[(size_t)t * 64 + lane];
            const unsigned e0 = ee & 0xffffu, e1 = ee >> 16;
            const bool f0 = (e0 >> 10) == slice, f1 = (e1 >> 10) == slice;
            const unsigned long long m0 = __ballot(f0), m1 = __ballot(f1);
            const unsigned long long below = (1ull << lane) - 1ull;
            const int n0 = __popcll(m0), cnt = n0 + __popcll(m1);
            if (f0) plist[__popcll(m0 & below)] = (unsigned)(2 * lane) | (e0 << 16);
            if (f1) plist[n0 + __popcll(m1 & below)] = (unsigned)(2 * lane + 1) | (e1 << 16);
            if (cnt == 0) continue;
            v4u xr[8];
#pragma unroll
            for (int i = 0; i < 8; ++i) xr[i] = *(const v4u*)(U2 + (size_t)t * D + 128 * i + 8 * j16);
            LDS_WAIT(); asm volatile("" ::: "memory");
            for (int pi = 0; pi < cnt; pi += 8) {
                const int i0 = pi + q, i1 = pi + 4 + q; const bool ok0 = i0 < cnt, ok1 = i1 < cnt;
                const unsigned p0 = plist[ok0 ? i0 : 0], p1 = plist[ok1 ? i1 : 0];
                const bf16* r0 = EU + (size_t)(p0 >> 16) * D + 8 * j16; const bf16* r1 = EU + (size_t)(p1 >> 16) * D + 8 * j16;
                v4u w0[8], w1[8];
#pragma unroll
                for (int i = 0; i < 8; ++i) { w0[i] = *(const v4u*)(r0 + 128 * i); w1[i] = *(const v4u*)(r1 + 128 * i); }
                float a0 = 0.f, a1 = 0.f, c0 = 0.f, c1 = 0.f;
#pragma unroll
                for (int i = 0; i < 8; ++i) { a0 = dot2_bf16(w0[i].x, xr[i].x, a0); a1 = dot2_bf16(w0[i].y, xr[i].y, a1); a0 = dot2_bf16(w0[i].z, xr[i].z, a0); a1 = dot2_bf16(w0[i].w, xr[i].w, a1);
                    c0 = dot2_bf16(w1[i].x, xr[i].x, c0); c1 = dot2_bf16(w1[i].y, xr[i].y, c1); c0 = dot2_bf16(w1[i].z, xr[i].z, c0); c1 = dot2_bf16(w1[i].w, xr[i].w, c1); }
                float h0 = a0 + a1, h1 = c0 + c1;
#pragma unroll
                for (int o = 1; o < 16; o <<= 1) { h0 += __shfl_xor(h0, o); h1 += __shfl_xor(h1, o); }
                if (j16 == 0) {
                    if (ok0) { float* gp = GATE + (size_t)t * 128 + (p0 & 0xffffu); *gp = gelu_exact(h0) * *gp; }
                    if (ok1) { float* gp = GATE + (size_t)t * 128 + (p1 & 0xffffu); *gp = gelu_exact(h1) * *gp; }
                }
            }
            LDS_WAIT(); asm volatile("" ::: "memory");
        }
    }
}

__device__ __forceinline__ void p11_v(Frame& F) {
    const int lane = F.lane, wave = F.wave, g8 = lane >> 3, c8 = lane & 7;
    LAS unsigned short* se = (LAS unsigned short*)(F.lds + wave * 1024);
    LAS float* sa = (LAS float*)(F.lds + wave * 1024 + 256);
    const bf16* EV = WSP(const bf16, WS_EV);
    const unsigned* EIDX2 = WSP(const unsigned, WS_EIDX); const float* ACT = WSP(const float, WS_GATE); bf16* FFN = WSP(bf16, WS_FFN);
    const int xg = F.bid & 7, rk = F.bid >> 3, nrk = (F.G - xg + 7) / 8;
    for (int pass = 0; pass < 2; ++pass) {
        const int slice = xg + 8 * pass;
        const bf16* evs = EV + 64 * slice + 8 * c8;
        for (int t = rk * NWAVES + wave; t < T; t += nrk * NWAVES) {
            *(LAS unsigned*)(se + 2 * lane) = EIDX2[(size_t)t * 64 + lane];
            *(LAS v2u*)(sa + 2 * lane) = *(const v2u*)(ACT + (size_t)t * 128 + 2 * lane);
            LDS_WAIT(); asm volatile("" ::: "memory");
            v4u vv[16]; float av[16];
#pragma unroll
            for (int i = 0; i < 16; ++i) { const int e = se[8 * i + g8]; av[i] = sa[8 * i + g8]; vv[i] = *(const v4u*)(evs + (size_t)e * D); }
            float acc[8];
#pragma unroll
            for (int k = 0; k < 8; ++k) acc[k] = 0.f;
#pragma unroll
            for (int i = 0; i < 16; ++i) { const float a = av[i];
                acc[0] += a * bflo(vv[i].x); acc[1] += a * bfhi(vv[i].x); acc[2] += a * bflo(vv[i].y); acc[3] += a * bfhi(vv[i].y);
                acc[4] += a * bflo(vv[i].z); acc[5] += a * bfhi(vv[i].z); acc[6] += a * bflo(vv[i].w); acc[7] += a * bfhi(vv[i].w); }
#pragma unroll
            for (int k = 0; k < 8; ++k) { acc[k] += __shfl_xor(acc[k], 8); acc[k] += __shfl_xor(acc[k], 16); acc[k] += __shfl_xor(acc[k], 32); }
            if (g8 == 0) { v4u o; o.x = pk2(acc[0], acc[1]); o.y = pk2(acc[2], acc[3]); o.z = pk2(acc[4], acc[5]); o.w = pk2(acc[6], acc[7]);
                *(v4u*)(FFN + (size_t)t * D + 64 * slice + 8 * c8) = o; }
            LDS_WAIT(); asm volatile("" ::: "memory");
        }
    }
}

__device__ __forceinline__ void p12_ln2(Frame& F) {
    const int gw = F.bid * NWAVES + F.wave, NGW = F.G * NWAVES, lane = F.lane;
    const float* COND = WSP(const float, WS_COND); const float* X1 = WSP(const float, WS_X1); const bf16* FFN = WSP(const bf16, WS_FFN);
    for (int t = gw; t < T; t += NGW) {
        const int b = t >> 12;
        const float* x1p = X1 + (size_t)t * D + 8 * lane; const float* g2 = COND + b * 6144 + 5 * 1024 + 8 * lane; const bf16* fp = FFN + (size_t)t * D + 8 * lane;
        float rv[16]; float s = 0.f;
#pragma unroll
        for (int hf = 0; hf < 2; ++hf) { const v4u fv = *(const v4u*)(fp + 512 * hf); const float ff[8] = {bflo(fv.x), bfhi(fv.x), bflo(fv.y), bfhi(fv.y), bflo(fv.z), bfhi(fv.z), bflo(fv.w), bfhi(fv.w)};
#pragma unroll
            for (int k4 = 0; k4 < 2; ++k4) { const f32x4 xv = *(const f32x4*)(x1p + 512 * hf + 4 * k4), gv = *(const f32x4*)(g2 + 512 * hf + 4 * k4);
#pragma unroll
                for (int e = 0; e < 4; ++e) { const float v = ALPHA * xv[e] + (1.0f + gv[e]) * ff[4 * k4 + e]; rv[8 * hf + 4 * k4 + e] = v; s += v; } } }
        const float mean = wave_sum(s) * (1.f / D); float s2 = 0.f;
#pragma unroll
        for (int k = 0; k < 16; ++k) { rv[k] -= mean; s2 += rv[k] * rv[k]; }
        const float rstd = rsqrtf(wave_sum(s2) * (1.f / D) + LN_EPS);
        float* op = F.out + (size_t)t * D + 8 * lane;
#pragma unroll
        for (int hf = 0; hf < 2; ++hf)
#pragma unroll
            for (int k4 = 0; k4 < 2; ++k4) { const f32x4 gg = *(const f32x4*)(F.ln2_g + 8 * lane + 512 * hf + 4 * k4), bb = *(const f32x4*)(F.ln2_b + 8 * lane + 512 * hf + 4 * k4); f32x4 o;
#pragma unroll
                for (int e = 0; e < 4; ++e) o[e] = rv[8 * hf + 4 * k4 + e] * rstd * gg[e] + bb[e];
                *(f32x4*)(op + 512 * hf + 4 * k4) = o; }
    }
}

constexpr int N_PHASES = 13;
struct Args { const float* in[23]; float* out; unsigned char* ws; int ph_lo, ph_hi; };
__global__ void __launch_bounds__(NT, 2) fwd_kernel(Args args) {
    extern __shared__ __attribute__((aligned(16))) unsigned char lds[];
    Frame F;
    F.lds = (LAS unsigned char*)lds;
    F.tid = threadIdx.x; F.lane = F.tid & 63; F.wave = __builtin_amdgcn_readfirstlane(F.tid >> 6);
    F.G = gridDim.x; F.bid = blockIdx.x;
    F.x = args.in[0]; F.c = args.in[1]; F.w_cond = args.in[2]; F.b_cond = args.in[3]; F.w_in = args.in[4]; F.sc_conv_w = args.in[5]; F.ssm_conv_w = args.in[6]; F.ssm_conv_b = args.in[7];
    F.dt_bias = args.in[8]; F.a_log = args.in[9]; F.d_skip = args.in[10]; F.sc_norm_w = args.in[11]; F.ssm_norm_w = args.in[12]; F.w_out = args.in[13]; F.ln1_g = args.in[14]; F.ln1_b = args.in[15];
    F.w_query = args.in[16]; F.sub_keys1 = args.in[17]; F.sub_keys2 = args.in[18]; F.expert_u = args.in[19]; F.expert_v = args.in[20]; F.ln2_g = args.in[21]; F.ln2_b = args.in[22];
    F.out = args.out; F.ws = args.ws;
    volatile LAS unsigned* MISC = (volatile LAS unsigned*)(F.lds + LDS_MISC);
    if (F.tid < 16) MISC[F.tid] = 0u;
    __syncthreads();
    const int lo = args.ph_lo, hi = args.ph_hi;
    XcdBarrier bar; bar.bar = (unsigned*)(F.ws + WS_CTL); bar.x = 0; bar.st = nullptr;
    if (hi - lo > 1) bar = xcd_barrier_post((unsigned*)(F.ws + WS_CTL), MISC + 8);
#ifndef PH_MASK
#define PH_MASK 0x1fff
#endif
#define IN(k) ((((PH_MASK) >> (k)) & 1) && lo <= (k) && (k) < hi)
#define SEAM(k) do { if (IN(k) && IN((k) + 1)) xcd_barrier(bar); } while (0)
    bf16* U1 = (bf16*)F.out; bf16* ST = (bf16*)F.out; float* PRE = F.out;
    if (IN(0)) { p0_prologue(F); } SEAM(0);
    if (IN(1)) { p1_modulate(F, U1); } SEAM(1);
    if (IN(2)) {
        pg8::Gemm g{U1, WSP(bf16, WS_WIN), T, N1, D, D, D, 1 << 30, 0}; pg8::StaticOrder S; S.init(T, N1, F.G, F.bid);
        pg8::EpiBf16 E{WSP(bf16, WS_PROJ), N1};
        pg8::gemm_phase<pg8::EpiBf16, pg8::StaticOrder>(F.lds, g, S, E);
    } SEAM(2);
    if (IN(3)) { for (int u = F.bid; u < NB * NCH * 2; u += F.G) p3_unit(F, u, ST); } SEAM(3);
    if (IN(4)) { p4_scan(F, ST); } SEAM(4);
    if (IN(5)) { for (int u = F.bid; u < NB * NCH * 2; u += F.G) p5_unit(F, u, ST); } SEAM(5);
    if (IN(6)) {
        pg8::Gemm g{WSP(bf16, WS_PROJ), WSP(bf16, WS_WOUT), T, D, 2048, N1, 2048, 16, (C_Z - 1024) * 2}; pg8::StaticOrder S; S.init(T, D, F.G, F.bid);
        pg8::EpiPre E{F.x, WSP(float, WS_COND) + 2 * 1024, PRE, ALPHA};
        pg8::gemm_phase<pg8::EpiPre, pg8::StaticOrder>(F.lds, g, S, E);
    } SEAM(6);
    if (IN(7)) { p7_ln1(F, PRE); } SEAM(7);
    if (IN(8)) {
        pg8::Gemm g{WSP(bf16, WS_U2), WSP(bf16, WS_WQ), T, 2048, D, D, D, 1 << 30, 0}; pg8::StaticOrder S; S.init(T, 2048, F.G, F.bid);
        pg8::EpiScores E{WSP(bf16, WS_SC)};
        pg8::gemm_phase<pg8::EpiScores, pg8::StaticOrder>(F.lds, g, S, E);
    } SEAM(8);
    if (IN(9)) { for (int tb = F.bid; tb < T / 64; tb += F.G) p9_topk(F, tb); } SEAM(9);
    if (IN(10)) { p10_u(F); } SEAM(10);
    if (IN(11)) { p11_v(F); } SEAM(11);
    if (IN(12)) { p12_ln2(F); }
#undef IN
#undef SEAM
}

extern "C" void kernel_launch(void* const* d_in, const int* in_sizes, int n_in, void* d_out, int out_size, void* d_ws, size_t ws_size, hipStream_t stream) {
    static int grid = 0;
    if (grid == 0) {
        if (n_in != 23 || out_size != T * D || ws_size < WS_END) { fprintf(stderr, "kernel_launch: unexpected shapes: n_in %d out %d ws %zu\n", n_in, out_size, ws_size); grid = -1; return; }
        int dev = 0, cus = 0, per_cu = 0;
        if (hipGetDevice(&dev) != hipSuccess || hipDeviceGetAttribute(&cus, hipDeviceAttributeMultiprocessorCount, dev) != hipSuccess) { grid = -1; return; }
        if (hipFuncSetAttribute((const void*)fwd_kernel, hipFuncAttributeMaxDynamicSharedMemorySize, LDS_BYTES) != hipSuccess) { fprintf(stderr, "kernel_launch: hipFuncSetAttribute failed\n"); grid = -1; return; }
        if (hipOccupancyMaxActiveBlocksPerMultiprocessor(&per_cu, (const void*)fwd_kernel, NT, LDS_BYTES) != hipSuccess || per_cu < 1) { fprintf(stderr, "kernel_launch: occupancy query says %d\n", per_cu); (void)hipGetLastError(); grid = -1; return; }
        grid = cus;
    }
    if (grid < 0) return;
    (void)hipMemsetAsync((char*)d_ws + WS_CTL, 0, CTL_ZERO_BYTES, stream);
    Args a{};
    for (int i = 0; i < 23; ++i) a.in[i] = (const float*)d_in[i];
    a.out = (float*)d_out; a.ws = (unsigned char*)d_ws;
#if MK_N_LAUNCHES == 1
    a.ph_lo = 0; a.ph_hi = N_PHASES;
    hipLaunchKernelGGL(fwd_kernel, dim3(grid), dim3(NT), LDS_BYTES, stream, a);
#else
    for (int p = 0; p < N_PHASES; ++p) { a.ph_lo = p; a.ph_hi = p + 1; hipLaunchKernelGGL(fwd_kernel, dim3(grid), dim3(NT), LDS_BYTES, stream, a); }
#endif
}
```

```cpp
#include <hip/hip_runtime.h>
#include <cstdio>
#include <cstdint>

#ifndef MK_N_LAUNCHES
#define MK_N_LAUNCHES 1
#endif

namespace pg8 {
#define PG8_LAS __attribute__((address_space(3)))
typedef unsigned short bf16_t;
typedef short bf16x8 __attribute__((ext_vector_type(8)));
typedef float f32x4 __attribute__((ext_vector_type(4)));
typedef unsigned u32x4 __attribute__((ext_vector_type(4)));
constexpr int BM = 256, BK = 64, HALF = 128, HTB = HALF * BK * 2  , STAGE_BYTES = 8 * HTB, NXCD = 8, WGM = 8;

__host__ __device__ __forceinline__ int lds_byte(int r, int c) { const int st = (r >> 4) * 2 + (c >> 5), rr = r & 15, cc = c & 31, ob = rr * 64 + cc * 2; return st * 1024 + (ob ^ (((ob >> 9) & 1) << 5)); }
__host__ __device__ __forceinline__ void stage_rc(int b, int& R, int& C) { const int st = b / 1024, sb = b % 1024, swz = sb ^ (((sb >> 9) & 1) << 5); R = (st >> 1) * 16 + swz / 64; C = (st & 1) * 32 + (swz % 64) / 2; }
__host__ __device__ __forceinline__ int perm32(int rho) { const int n = rho >> 4, i = rho & 15; return 8 * (i >> 2) + 4 * n + (i & 3); }

struct Unit { int pm, pn; };
struct Gemm { const bf16_t* A; const bf16_t* Bt; int M, N, K, lda, ldb, ksplit, kjump; };

struct StaticOrder {
    int nM, nN, nwg, G, c;
    __host__ __device__ void init(int M, int N, int G_, int c_) { nM = M / BM; nN = N / BM; nwg = nM * nN; G = G_; c = c_; }
    __host__ __device__ bool next(int i, Unit& u) const {
        const long L = (long)i * G + c; if (L >= nwg) return false;
        int wgid = (int)L; { const int q = nwg / NXCD, r = nwg % NXCD, xcd = wgid % NXCD, off = wgid / NXCD; wgid = (xcd < r ? xcd * (q + 1) : r * (q + 1) + (xcd - r) * q) + off; }
        const int nig = WGM * nN, gid = wgid / nig, fm = gid * WGM, gsz = (nM - fm) < WGM ? (nM - fm) : WGM;
        u.pm = fm + ((wgid % nig) % gsz); u.pn = (wgid % nig) / gsz; return true;
    }
    __device__ __forceinline__ void a_ready(const Unit&) const {}
    __device__ __forceinline__ void done(const Unit&) const {}
};

__device__ __forceinline__ unsigned cvt_pk_bf16(float lo, float hi) { unsigned r; asm volatile("v_cvt_pk_bf16_f32 %0, %1, %2" : "=v"(r) : "v"(lo), "v"(hi)); return r; }

struct EpiBf16 {
    static constexpr bool PERM = true;
    bf16_t* O; int ldc;
    __device__ __forceinline__ void operator()(const f32x4 (&acc)[2][2][4][2], const Unit& u, int wr, int wc, int fr, int fq) const {
        const int row0 = u.pm * BM + wr * 64 + fr; const int col0 = u.pn * BM + wc * 32 + 8 * fq;
#pragma unroll
        for (int ai = 0; ai < 2; ++ai)
#pragma unroll
            for (int m = 0; m < 4; ++m) { bf16_t* rowp = O + (size_t)(row0 + ai * HALF + m * 16) * ldc + col0;
#pragma unroll
                for (int bj = 0; bj < 2; ++bj) { const f32x4 v0 = acc[ai][bj][m][0], v1 = acc[ai][bj][m][1];
                    u32x4 w; w.x = cvt_pk_bf16(v0[0], v0[1]); w.y = cvt_pk_bf16(v0[2], v0[3]); w.z = cvt_pk_bf16(v1[0], v1[1]); w.w = cvt_pk_bf16(v1[2], v1[3]);
                    *(u32x4*)(rowp + bj * HALF) = w; } }
    }
};
struct EpiScores {
    static constexpr bool PERM = true;
    bf16_t* O;
    __device__ __forceinline__ void operator()(const f32x4 (&acc)[2][2][4][2], const Unit& u, int wr, int wc, int fr, int fq) const {
        const int kc = 4 * wc + fq;
#pragma unroll
        for (int ai = 0; ai < 2; ++ai)
#pragma unroll
            for (int m = 0; m < 4; ++m) { const int r = u.pm * BM + ai * HALF + wr * 64 + m * 16 + fr; const int tb = r >> 6, tok = r & 63;
#pragma unroll
                for (int bj = 0; bj < 2; ++bj) { const f32x4 v0 = acc[ai][bj][m][0], v1 = acc[ai][bj][m][1]; const int hh = 2 * u.pn + bj;
                    u32x4 w; w.x = cvt_pk_bf16(v0[0], v0[1]); w.y = cvt_pk_bf16(v0[2], v0[3]); w.z = cvt_pk_bf16(v1[0], v1[1]); w.w = cvt_pk_bf16(v1[2], v1[3]);
                    *(u32x4*)(O + ((((size_t)tb * 16 + hh) * 16 + kc) * 64 + tok) * 8) = w; } }
    }
};
struct EpiPre {
    static constexpr bool PERM = false;
    const float* x; const float* gate; float* out; float alpha;
    __device__ __forceinline__ void operator()(const f32x4 (&acc)[2][2][4][2], const Unit& u, int wr, int wc, int fr, int fq) const {
        const int row0 = u.pm * BM + wr * 64 + fr, col0 = u.pn * BM + wc * 32 + 4 * fq; const int b = (u.pm * BM) >> 12;
        f32x4 gv[2][2];
#pragma unroll
        for (int bj = 0; bj < 2; ++bj)
#pragma unroll
            for (int n = 0; n < 2; ++n) gv[bj][n] = *(const f32x4*)(gate + b * 6144 + col0 + bj * HALF + n * 16) + 1.0f;
#pragma unroll
        for (int ai = 0; ai < 2; ++ai)
#pragma unroll
            for (int m = 0; m < 4; ++m) { const size_t off = (size_t)(row0 + ai * HALF + m * 16) * 1024 + col0;
#pragma unroll
                for (int bj = 0; bj < 2; ++bj)
#pragma unroll
                    for (int n = 0; n < 2; ++n) { const f32x4 xv = *(const f32x4*)(x + off + bj * HALF + n * 16);
                        *(f32x4*)(out + off + bj * HALF + n * 16) = xv * alpha + gv[bj][n] * acc[ai][bj][m][n]; }
                asm volatile("" ::: "memory"); }
    }
};

template <class Epi, class Sched, bool ALIGN_EPI = true>
__device__ __forceinline__ void gemm_phase(PG8_LAS unsigned char* lds, const Gemm g, const Sched& S, const Epi& E) {
    const int tid = threadIdx.x, wid = __builtin_amdgcn_readfirstlane(tid >> 6), lane = tid & 63, wr = wid >> 2, wc = wid & 3, fr = lane & 15, fq = lane >> 4;
    const int K = g.K, nt = K / BK;
    unsigned voffA[2], voffB[2];
#pragma unroll
    for (int i = 0; i < 2; ++i) { int R, C; stage_rc(tid * 16 + i * 8192, R, C); const int Rb = Epi::PERM ? ((R & ~31) + perm32(R & 31)) : R;
        voffA[i] = (unsigned)(R * g.lda + C) * 2u; voffB[i] = (unsigned)(Rb * g.ldb + C) * 2u; }
    const size_t kstep = (size_t)(BK * 2);
    const size_t hstepA = (size_t)HALF * g.lda * 2, hstepB = (size_t)HALF * g.ldb * 2;
    const size_t tstepA = 2 * hstepA, tstepB = 2 * hstepB;
    const unsigned ldsw = (unsigned)wid * 1024u;
    const int aoff = lds_byte(wr * 64 + fr, fq * 8), boff = lds_byte(wc * 32 + fr, fq * 8);
#define PG8_SA(b, h) (((b) * 2 + (h)) * HTB)
#define PG8_SB(b, h) ((4 + (b) * 2 + (h)) * HTB)
#define PG8_STAGE(bufoff, gbase, voff) do { _Pragma("unroll") for (int _i = 0; _i < 2; ++_i) \
        __builtin_amdgcn_global_load_lds((const unsigned*)((const char*)(gbase) + (voff)[_i]), (PG8_LAS unsigned*)(lds + (bufoff) + ldsw + _i * 8192), 16, 0, 0); } while (0)
#define PG8_LDA(dst, b, h) do { _Pragma("unroll") for (int m = 0; m < 4; ++m) _Pragma("unroll") for (int k = 0; k < 2; ++k) dst[m][k] = *(const PG8_LAS bf16x8*)(lds + PG8_SA(b, h) + aoff + m * 2048 + k * 1024); } while (0)
#define PG8_LDB(dst, b, h) do { _Pragma("unroll") for (int n = 0; n < 2; ++n) _Pragma("unroll") for (int k = 0; k < 2; ++k) dst[n][k] = *(const PG8_LAS bf16x8*)(lds + PG8_SB(b, h) + boff + n * 2048 + k * 1024); } while (0)
#define PG8_MMA(ai, bj, At, Bt) do { __builtin_amdgcn_s_setprio(1); _Pragma("unroll") for (int m = 0; m < 4; ++m) _Pragma("unroll") for (int n = 0; n < 2; ++n) _Pragma("unroll") for (int k = 0; k < 2; ++k) \
        acc[ai][bj][m][n] = __builtin_amdgcn_mfma_f32_16x16x32_bf16(Bt[n][k], At[m][k], acc[ai][bj][m][n], 0, 0, 0); __builtin_amdgcn_s_setprio(0); } while (0)
#define PG8_WAIT_V(n) asm volatile("s_waitcnt vmcnt(" #n ")" ::: "memory")
#define PG8_WAIT_L(n) asm volatile("s_waitcnt lgkmcnt(" #n ")" ::: "memory")
#define PG8_BAR __builtin_amdgcn_s_barrier()
#define PG8_SCHED __builtin_amdgcn_sched_barrier(0)
#define PG8_AT(base, t) ((base) + (size_t)(t) * kstep + ((t) >= g.ksplit ? (size_t)g.kjump : (size_t)0))
    Unit cur, nxt; int ui = 0;
    if (!S.next(0, cur)) return;
    f32x4 acc[2][2][4][2];
#pragma unroll
    for (int a = 0; a < 2; ++a)
#pragma unroll
        for (int b = 0; b < 2; ++b)
#pragma unroll
            for (int m = 0; m < 4; ++m)
#pragma unroll
                for (int n = 0; n < 2; ++n) acc[a][b][m][n] = (f32x4){0.f, 0.f, 0.f, 0.f};
    bf16x8 At[4][2], B0[2][2], B1[2][2];
    const char* cA = (const char*)g.A + (size_t)cur.pm * tstepA; const char* cB = (const char*)g.Bt + (size_t)cur.pn * tstepB;
    S.a_ready(cur);
    PG8_STAGE(PG8_SB(0, 0), cB, voffB); PG8_STAGE(PG8_SB(0, 1), cB + hstepB, voffB); PG8_STAGE(PG8_SA(0, 0), cA, voffA); PG8_STAGE(PG8_SA(0, 1), cA + hstepA, voffA);
    if (wr == 1) PG8_BAR;
    PG8_WAIT_V(2); PG8_BAR;
    PG8_STAGE(PG8_SB(1, 0), cB + kstep, voffB); PG8_STAGE(PG8_SA(1, 0), cA + kstep, voffA); PG8_STAGE(PG8_SB(1, 1), cB + hstepB + kstep, voffB);
    PG8_WAIT_V(6); PG8_BAR;
    for (;;) {
        const bool has_next = S.next(ui + 1, nxt);
        const char* nA = has_next ? (const char*)g.A + (size_t)nxt.pm * tstepA : cA; const char* nB = has_next ? (const char*)g.Bt + (size_t)nxt.pn * tstepB : cB;
        for (int t = 0; t < nt; t += 2) {
            const bool last = (t == nt - 2);
            const char* a1 = PG8_AT(cA, t + 1);
            const char* a2 = last ? nA : PG8_AT(cA, t + 2); const char* b2 = last ? nB : cB + (size_t)(t + 2) * kstep;
            const char* a3 = a2 + kstep; const char* b3 = b2 + kstep;
            if (last && has_next) S.a_ready(nxt);
            PG8_LDB(B0, 0, 0); PG8_LDB(B1, 0, 1); PG8_SCHED; PG8_LDA(At, 0, 0); PG8_STAGE(PG8_SA(1, 1), a1 + hstepA, voffA);
            PG8_WAIT_V(8); PG8_WAIT_L(0); PG8_BAR; PG8_MMA(0, 0, At, B0); PG8_MMA(0, 1, At, B1); PG8_BAR; PG8_SCHED;
            PG8_LDA(At, 0, 1); PG8_STAGE(PG8_SB(0, 0), b2, voffB); PG8_STAGE(PG8_SB(0, 1), b2 + hstepB, voffB); PG8_STAGE(PG8_SA(0, 0), a2, voffA);
            PG8_WAIT_V(8); PG8_WAIT_L(0); PG8_BAR; PG8_MMA(1, 0, At, B0); PG8_MMA(1, 1, At, B1); PG8_BAR; PG8_SCHED;
            PG8_LDB(B0, 1, 0); PG8_LDB(B1, 1, 1); PG8_SCHED; PG8_LDA(At, 1, 0); PG8_STAGE(PG8_SA(0, 1), a2 + hstepA, voffA);
            PG8_WAIT_V(8); PG8_WAIT_L(0); PG8_BAR; PG8_MMA(0, 0, At, B0); PG8_MMA(0, 1, At, B1); PG8_BAR; PG8_SCHED;
            PG8_LDA(At, 1, 1); PG8_STAGE(PG8_SB(1, 0), b3, voffB); PG8_STAGE(PG8_SB(1, 1), b3 + hstepB, voffB); PG8_STAGE(PG8_SA(1, 0), a3, voffA);
            PG8_WAIT_V(8); PG8_WAIT_L(0); PG8_BAR; PG8_MMA(1, 0, At, B0); PG8_MMA(1, 1, At, B1); PG8_BAR; PG8_SCHED;
        }
        if constexpr (ALIGN_EPI) { if (wr == 0) PG8_BAR; }
        E(acc, cur, wr, wc, fr, fq); S.done(cur);
        if (!has_next) break;
#pragma unroll
        for (int a = 0; a < 2; ++a)
#pragma unroll
            for (int b = 0; b < 2; ++b)
#pragma unroll
                for (int m = 0; m < 4; ++m)
#pragma unroll
                    for (int n = 0; n < 2; ++n) acc[a][b][m][n] = (f32x4){0.f, 0.f, 0.f, 0.f};
        cur = nxt; cA = nA; cB = nB; ++ui;
        if constexpr (ALIGN_EPI) { if (wr == 1) PG8_BAR; }
    }
    PG8_WAIT_V(0);
    if constexpr (!ALIGN_EPI) { if (wr == 0) PG8_BAR; }
    PG8_BAR;
#undef PG8_SA
#undef PG8_SB
#undef PG8_STAGE
#undef PG8_LDA
#undef PG8_LDB
#undef PG8_MMA
#undef PG8_WAIT_V
#undef PG8_WAIT_L
#undef PG8_BAR
#undef PG8_SCHED
#undef PG8_AT
}
}

constexpr int NWAVES = 8, NT = 512;
constexpr int T = 16384, D = 1024, SEQ = 4096, NB = 4;
constexpr int INW = 5648, N1 = 5632;
constexpr int C_SCB = 0, C_SCC = 1024, C_SCH = 2048, C_Z = 3072, C_X = 4096, C_B = 5120, C_C = 5376, C_DT = 5632;
constexpr int NCH = 32, LCH = 128;
constexpr float ALPHA = 1.189207115f;
constexpr float LN_EPS = 1e-5f, RMS_EPS = 1e-6f;

constexpr size_t MiB = 1024 * 1024;
constexpr size_t WS_CTL = 0, CTL_ZERO_BYTES = 65536;
constexpr size_t WS_COND = 65536;
constexpr size_t WS_WOUT = 1 * MiB;
constexpr size_t WS_WQ = 5 * MiB;
constexpr size_t WS_WIN = 9 * MiB;
constexpr size_t WS_DT = 20 * MiB;
constexpr size_t WS_ACUM = 21 * MiB;
constexpr size_t WS_PROJ = 24 * MiB;
constexpr size_t WS_CN = 200 * MiB;
constexpr size_t WS_CB = 208 * MiB;
constexpr size_t WS_XT = 216 * MiB;
constexpr size_t WS_X1 = 24 * MiB;
constexpr size_t WS_U2 = 88 * MiB;
constexpr size_t WS_SC = 120 * MiB;
constexpr size_t WS_EU = 184 * MiB;
constexpr size_t WS_EV = 200 * MiB;
constexpr size_t WS_XQ = 216 * MiB;
constexpr size_t WS_SU = 232 * MiB;
constexpr size_t WS_SV = 232 * MiB + 65536;
constexpr size_t WS_XS = 232 * MiB + 131072;
constexpr size_t WS_EIDX = 9 * MiB;
constexpr size_t WS_GATE = 248 * MiB;
constexpr size_t WS_ACT = 13 * MiB;
constexpr size_t WS_FFN = 120 * MiB;
constexpr size_t WS_END = 256 * MiB;

constexpr int LDS_BYTES = 147456;
constexpr int LDS_MISC = 143360;

#define GAS __attribute__((address_space(1)))
#define LAS __attribute__((address_space(3)))
typedef unsigned short bf16;
typedef unsigned v4u __attribute__((ext_vector_type(4)));
typedef unsigned v2u __attribute__((ext_vector_type(2)));
typedef float f32x4 __attribute__((ext_vector_type(4)));
typedef short bf16x8 __attribute__((ext_vector_type(8)));
typedef __bf16 bf16x2_t __attribute__((ext_vector_type(2)));
#define LDS_WAIT() asm volatile("s_waitcnt lgkmcnt(0)" ::: "memory")
__device__ __forceinline__ unsigned f2bf(float f) { unsigned u = __builtin_bit_cast(unsigned, f); return (u + 0x7fffu + ((u >> 16) & 1u)) >> 16; }
__device__ __forceinline__ unsigned pk2(float lo, float hi) { return f2bf(lo) | (f2bf(hi) << 16); }
__device__ __forceinline__ float bflo(unsigned u) { return __builtin_bit_cast(float, u << 16); }
__device__ __forceinline__ float bfhi(unsigned u) { return __builtin_bit_cast(float, u & 0xffff0000u); }
__device__ __forceinline__ float bf1(bf16 b) { return __builtin_bit_cast(float, (unsigned)b << 16); }
__device__ __forceinline__ float wave_sum(float v) {
#pragma unroll
    for (int o = 1; o < 64; o <<= 1) v += __shfl_xor(v, o);
    return v;
}
__device__ __forceinline__ float silu_f(float v) { return v / (1.0f + __expf(-v)); }
__device__ __forceinline__ float dot2_bf16(unsigned w, unsigned x, float acc) { return __builtin_amdgcn_fdot2_f32_bf16(__builtin_bit_cast(bf16x2_t, w), __builtin_bit_cast(bf16x2_t, x), acc, false); }
__device__ __forceinline__ f32x4 mfma16(bf16x8 a, bf16x8 b, f32x4 c) { return __builtin_amdgcn_mfma_f32_16x16x32_bf16(a, b, c, 0, 0, 0); }

#define XB_TMO      128
#define XB_XCNT(j)  (256  + 64 * (j))
#define XB_XSUB(j)  (1280 + 64 * (j))
#define XB_XGEN(j)  (2304 + 64 * (j))
#define XB_TOP      3328
#define XB_TOPGEN   3392
#define XCD_BAR_WORDS 3456
#define XB_SPIN_CAP (1u << 18)
__device__ __forceinline__ unsigned xb_ld(unsigned* p)              { return __hip_atomic_load(p, __ATOMIC_RELAXED, __HIP_MEMORY_SCOPE_AGENT); }
__device__ __forceinline__ unsigned xb_add(unsigned* p, unsigned v) { return __hip_atomic_fetch_add(p, v, __ATOMIC_RELAXED, __HIP_MEMORY_SCOPE_AGENT); }
__device__ __forceinline__ unsigned xb_xcc_id() { return (unsigned)__builtin_amdgcn_s_getreg((3 << 11) | 20) & 0xFu; }
#define XB_SPIN(cond, bar) do { unsigned _sp = 0; while (cond) { __builtin_amdgcn_s_sleep(1); \
    if ((++_sp & 255u) == 0u) { if (xb_ld(&(bar)[XB_TMO])) break; if (_sp > XB_SPIN_CAP) { atomicAdd(&(bar)[XB_TMO], 1u); break; } } } } while (0)
struct XcdBarrier { unsigned* bar; unsigned x; volatile LAS unsigned* st; };
__device__ __forceinline__ XcdBarrier xcd_barrier_post(unsigned* bar, volatile LAS unsigned* st) {
    XcdBarrier b; b.bar = bar; b.x = xb_xcc_id(); b.st = st;
    if (threadIdx.x == 0) (void)xb_add(&bar[XB_XCNT(b.x)], 1u);
    return b;
}
__device__ __forceinline__ void xcd_barrier_complete(unsigned* bar, unsigned x, unsigned& nloc, unsigned& nx) {
    const unsigned G = gridDim.x * gridDim.y * gridDim.z;
    unsigned sum, cnt, mine, sp = 0u;
    for (;;) {
        sum = 0u; cnt = 0u; mine = 0u;
#pragma unroll
        for (unsigned j = 0; j < 16; ++j) { const unsigned c = xb_ld(&bar[XB_XCNT(j)]); sum += c; cnt += (c > 0u) ? 1u : 0u; mine = (j == x) ? c : mine; }
        if (sum == G) break;
        __builtin_amdgcn_s_sleep(1);
        if ((++sp & 255u) == 0u) { if (xb_ld(&bar[XB_TMO])) break; if (sp > XB_SPIN_CAP) { atomicAdd(&bar[XB_TMO], 1u); break; } }
    }
    nloc = mine > 0u ? mine : 1u; nx = cnt > 0u ? cnt : 1u;
}
__device__ __forceinline__ void xcd_barrier(const XcdBarrier& b) {
    asm volatile("s_waitcnt vmcnt(0)" ::: "memory");
    __syncthreads();
    if (threadIdx.x == 0) {
        unsigned* bar = b.bar;
        __builtin_amdgcn_s_waitcnt(0);
        unsigned nloc = b.st[0], nx = b.st[1];
        if (nloc == 0u) { xcd_barrier_complete(bar, b.x, nloc, nx); b.st[0] = nloc; b.st[1] = nx; }
        const unsigned old = xb_add(&bar[XB_XSUB(b.x)], 1u);
        const unsigned gen = old / nloc;
        if (old + 1u == (gen + 1u) * nloc) {
            __builtin_amdgcn_fence(__ATOMIC_RELEASE, "agent");
            asm volatile("s_waitcnt vmcnt(0)" ::: "memory");
            const unsigned og = xb_add(&bar[XB_TOP], 1u);
            const unsigned tg = og / nx;
            if (og + 1u == (tg + 1u) * nx) xb_add(&bar[XB_TOPGEN], 1u);
            else XB_SPIN(xb_ld(&bar[XB_TOPGEN]) == tg, bar);
            __builtin_amdgcn_fence(__ATOMIC_ACQUIRE, "agent");
            xb_add(&bar[XB_XGEN(b.x)], 1u);
            asm volatile("s_waitcnt vmcnt(0)" ::: "memory");
        } else {
            XB_SPIN(xb_ld(&bar[XB_XGEN(b.x)]) == gen, bar);
            __builtin_amdgcn_fence(__ATOMIC_ACQUIRE, "agent");
            asm volatile("s_waitcnt vmcnt(0)" ::: "memory");
        }
    }
    __syncthreads();
}

struct Frame {
    LAS unsigned char* lds;
    int tid, lane, wave, G, bid;
    const float *x, *c, *w_cond, *b_cond, *w_in, *sc_conv_w, *ssm_conv_w, *ssm_conv_b, *dt_bias, *a_log, *d_skip, *sc_norm_w, *ssm_norm_w, *w_out, *ln1_g, *ln1_b,
                *w_query, *sub_keys1, *sub_keys2, *expert_u, *expert_v, *ln2_g, *ln2_b;
    float* out; unsigned char* ws;
};

#define WSP(T_, off) ((T_*)(F.ws + (off)))

__device__ __forceinline__ void p0_transpose_item(const float* W, int ldw, int K, int Nn, bf16* WT, LAS float* scr, int item, int lane) {
    const int nblk = Nn / 32, kb = item / nblk, nb = item % nblk, k0 = 64 * kb, n0 = 32 * nb;
#pragma unroll 8
    for (int i = 0; i < 32; ++i) { const int kk = 2 * i + (lane >> 5); scr[kk * 33 + (lane & 31)] = W[(size_t)(k0 + kk) * ldw + n0 + (lane & 31)]; }
    LDS_WAIT(); asm volatile("" ::: "memory");
    const int c = lane & 7;
#pragma unroll
    for (int j = 0; j < 4; ++j) { const int n = (lane >> 3) + 8 * j; const LAS float* s = scr + (8 * c) * 33 + n;
        v4u o; o.x = pk2(s[0 * 33], s[1 * 33]); o.y = pk2(s[2 * 33], s[3 * 33]); o.z = pk2(s[4 * 33], s[5 * 33]); o.w = pk2(s[6 * 33], s[7 * 33]);
        *(v4u*)(WT + (size_t)(n0 + n) * K + k0 + 8 * c) = o; }
    LDS_WAIT(); asm volatile("" ::: "memory");
}
__device__ __forceinline__ void p0_wq(Frame& F, int task) {
    const int hh = task >> 4, d0 = 64 * (task & 15), h = hh >> 1, half = hh & 1, tid = F.tid;
    LAS float* keys = (LAS float*)F.lds;
    LAS float* wq = keys + 128 * 128;
    const float* kp = (half ? F.sub_keys2 : F.sub_keys1) + (size_t)h * 128 * 128;
    for (int i = tid; i < 4096; i += NT) ((LAS f32x4*)keys)[i] = ((const f32x4*)kp)[i];
    for (int i = tid; i < 64 * 32; i += NT) { const int r = i >> 5, c4 = i & 31; *(LAS f32x4*)(wq + r * 132 + 4 * c4) = *(const f32x4*)(F.w_query + (size_t)(d0 + r) * 2048 + hh * 128 + 4 * c4); }
    __syncthreads();
    const int d = tid & 63, kg = tid >> 6;
    float acc[16];
#pragma unroll
    for (int k = 0; k < 16; ++k) acc[k] = 0.f;
    for (int j4 = 0; j4 < 32; ++j4) { const f32x4 w = *(LAS f32x4*)(wq + d * 132 + 4 * j4);
#pragma unroll
        for (int k = 0; k < 16; ++k) { const f32x4 kv = *(LAS f32x4*)(keys + (16 * kg + k) * 128 + 4 * j4); acc[k] += (kv.x * w.x + kv.y * w.y) + (kv.z * w.z + kv.w * w.w); } }
    bf16* WQ = WSP(bf16, WS_WQ);
#pragma unroll
    for (int k = 0; k < 16; ++k) WQ[(size_t)(hh * 128 + 16 * kg + k) * 1024 + d0 + d] = (bf16)f2bf(acc[k]);
    __syncthreads();
}
__device__ __forceinline__ void p0_cond(Frame& F, int task) {
    const int tid = F.tid;
    LAS float* sc = (LAS float*)F.lds;
    LAS float* red = sc + 4096;
    for (int i = tid; i < 4096; i += NT) sc[i] = silu_f(F.c[i]);
    __syncthreads();
    const int l8 = tid & 7, rs = tid >> 3;
    const float* wp = F.w_cond + (size_t)rs * 6144 + 32 * task + 4 * l8;
    f32x4 w[16];
#pragma unroll
    for (int i = 0; i < 16; ++i) w[i] = *(const f32x4*)(wp + (size_t)i * 64 * 6144);
    f32x4 acc[4];
#pragma unroll
    for (int b = 0; b < 4; ++b) acc[b] = (f32x4){0.f, 0.f, 0.f, 0.f};
#pragma unroll
    for (int i = 0; i < 16; ++i)
#pragma unroll
        for (int b = 0; b < 4; ++b) acc[b] += w[i] * sc[b * 1024 + 64 * i + rs];
#pragma unroll
    for (int b = 0; b < 4; ++b)
#pragma unroll
        for (int e = 0; e < 4; ++e) { float v = acc[b][e]; v += __shfl_xor(v, 8); v += __shfl_xor(v, 16); v += __shfl_xor(v, 32); if ((F.lane >> 3) == 0) red[(F.wave * 8 + l8) * 16 + b * 4 + e] = v; }
    __syncthreads();
    if (tid < 128) { const int b = tid >> 5, col = tid & 31, q8 = col >> 2, e = col & 3; float s = 0.f;
#pragma unroll
        for (int wv = 0; wv < 8; ++wv) s += red[(wv * 8 + q8) * 16 + b * 4 + e];
        WSP(float, WS_COND)[b * 6144 + 32 * task + col] = s + F.b_cond[32 * task + col]; }
    __syncthreads();
}
__device__ __forceinline__ void p0_prologue(Frame& F) {
    for (int task = F.bid; task < 256; task += F.G) p0_wq(F, task);
    for (int task = F.bid; task < 192; task += F.G) p0_cond(F, task);
    LAS float* scr = (LAS float*)(F.lds + F.wave * 16384);
    const int gw = F.bid * NWAVES + F.wave, NGW = F.G * NWAVES;
    constexpr int I_IN = (D / 64) * (N1 / 32), I_OUT = (2048 / 64) * (1024 / 32);
    for (int it = gw; it < I_IN + I_OUT; it += NGW) {
        if (it < I_IN) p0_transpose_item(F.w_in, INW, D, N1, WSP(bf16, WS_WIN), scr, it, F.lane);
        else p0_transpose_item(F.w_out, 1024, 2048, 1024, WSP(bf16, WS_WOUT), scr, it - I_IN, F.lane);
    }
}

__device__ __forceinline__ void p1_modulate(Frame& F, bf16* U1) {
    LAS float* wdt = (LAS float*)F.lds;
    for (int i = F.tid; i < 16384; i += NT) { const int d = i >> 4, h = i & 15; wdt[h * 1024 + d] = F.w_in[(size_t)d * INW + C_DT + h]; }
    __syncthreads();
    const int gw = F.bid * NWAVES + F.wave, NGW = F.G * NWAVES, lane = F.lane;
    const float* COND = WSP(float, WS_COND); float* DT = WSP(float, WS_DT);
    for (int m = gw; m < T; m += NGW) {
        const int b = m >> 12; const float* cd = COND + b * 6144;
        const f32x4* xr = (const f32x4*)(F.x + (size_t)m * D) + lane;
        float part[16];
#pragma unroll
        for (int h = 0; h < 16; ++h) part[h] = 0.f;
#pragma unroll 1
        for (int j = 0; j < 4; ++j) { const int col = 4 * lane + 256 * j; const f32x4 v = xr[64 * j], sh = *(const f32x4*)(cd + col), scl = *(const f32x4*)(cd + 1024 + col);
            const f32x4 u = v * (scl + 1.0f) + sh;
            v2u o; o.x = pk2(u.x, u.y); o.y = pk2(u.z, u.w); *(v2u*)(U1 + (size_t)m * D + col) = o;
#pragma unroll
            for (int h = 0; h < 16; ++h) { const f32x4 w = *(LAS f32x4*)(wdt + h * 1024 + col); part[h] += (u.x * w.x + u.y * w.y) + (u.z * w.z + u.w * w.w); } }
        float mine = 0.f;
#pragma unroll
        for (int h = 0; h < 16; ++h) { const float s = wave_sum(part[h]); mine = (lane == h) ? s : mine; }
        if (lane < 16) { const float v = mine + F.dt_bias[lane]; DT[(size_t)m * 16 + lane] = v > 20.f ? v : log1pf(__expf(v)); }
    }
}

constexpr int RS = 272;
__device__ __forceinline__ void p3_unit(Frame& F, int unit, bf16* ST) {
    const int g = unit & 1, bc = unit >> 1, b = bc >> 5, c = bc & 31, t0 = b * SEQ + c * LCH, tid = F.tid, lane = F.lane, wave = F.wave;
    const int r = lane & 15, q = lane >> 4;
    LAS unsigned char* BT = F.lds;
    LAS unsigned char* R1 = F.lds + 34816;
    LAS unsigned char* Bnat = R1; LAS unsigned char* Cnat = R1 + 34816; LAS unsigned char* xwT = R1;
    LAS float* acum_s = (LAS float*)(F.lds + 104448);
    LAS float* wts = acum_s + 1024;
    const bf16* PROJ = WSP(bf16, WS_PROJ); const float* DT = WSP(const float, WS_DT); float* ACUM = WSP(float, WS_ACUM);
    {
        const int h = 8 * g + wave; const float a = -__expf(F.a_log[h]);
        const float d0 = DT[(size_t)(t0 + 2 * lane) * 16 + h], d1 = DT[(size_t)(t0 + 2 * lane + 1) * 16 + h];
        const float v0 = a * d0, v1 = a * d1; float s = v0 + v1;
#pragma unroll
        for (int o = 1; o < 64; o <<= 1) { const float t = __shfl_up(s, o); if (lane >= o) s += t; }
        float ex = __shfl_up(s, 1); if (lane == 0) ex = 0.f;
        const float c0 = ex + v0, c1 = c0 + v1, end = __shfl(s, 63);
        acum_s[wave * 128 + 2 * lane] = c0; acum_s[wave * 128 + 2 * lane + 1] = c1;
        wts[wave * 128 + 2 * lane] = d0 * __expf(end - c0); wts[wave * 128 + 2 * lane + 1] = d1 * __expf(end - c1);
        ACUM[(size_t)(t0 + 2 * lane) * 16 + h] = c0; ACUM[(size_t)(t0 + 2 * lane + 1) * 16 + h] = c1;
    }
    {
        const int ch = tid & 255, lh = tid >> 8, isC = ch >> 7, n = ch & 127;
        const int col = C_B + isC * 256 + 128 * g + n, cw = 1024 + isC * 256 + 128 * g + n;
        const float w0 = F.ssm_conv_w[cw], w1 = F.ssm_conv_w[1536 + cw], w2 = F.ssm_conv_w[2 * 1536 + cw], w3 = F.ssm_conv_w[3 * 1536 + cw], bias = F.ssm_conv_b[cw];
        const bf16* p = PROJ + (size_t)(t0 + 64 * lh) * N1 + col;
        float h0 = 0.f, h1 = 0.f, h2 = 0.f;
        if (!(c == 0 && lh == 0)) { h0 = bf1(p[-3 * N1]); h1 = bf1(p[-2 * N1]); h2 = bf1(p[-1 * N1]); }
        bf16* CN = WSP(bf16, WS_CN);
        for (int st = 0; st < 8; ++st) {
            float raw[8]; unsigned ob[8];
#pragma unroll
            for (int i = 0; i < 8; ++i) raw[i] = bf1(p[(size_t)(st * 8 + i) * N1]);
#pragma unroll
            for (int i = 0; i < 8; ++i) { const float v = w0 * h0 + w1 * h1 + w2 * h2 + w3 * raw[i] + bias; h0 = h1; h1 = h2; h2 = raw[i]; ob[i] = f2bf(silu_f(v)); }
            const int l = 64 * lh + 8 * st;
            if (!isC) {
                v4u pk; pk.x = ob[0] | (ob[1] << 16); pk.y = ob[2] | (ob[3] << 16); pk.z = ob[4] | (ob[5] << 16); pk.w = ob[6] | (ob[7] << 16);
                *(LAS v4u*)(BT + n * RS + l * 2) = pk;
#pragma unroll
                for (int i = 0; i < 8; ++i) *(LAS bf16*)(Bnat + (l + i) * RS + n * 2) = (bf16)ob[i];
            } else {
#pragma unroll
                for (int i = 0; i < 8; ++i) { *(LAS bf16*)(Cnat + (l + i) * RS + n * 2) = (bf16)ob[i]; CN[(size_t)(t0 + l + i) * 256 + 128 * g + n] = (bf16)ob[i]; }
            }
        }
    }
    __syncthreads();
    {
        const int l0 = 16 * wave; bf16x8 cf[4];
#pragma unroll
        for (int ks = 0; ks < 4; ++ks) cf[ks] = *(LAS bf16x8*)(Cnat + (l0 + r) * RS + (32 * ks + 8 * q) * 2);
        bf16* CBG = WSP(bf16, WS_CB) + (size_t)unit * 16384;
#pragma unroll
        for (int st = 0; st < 8; ++st) { f32x4 acc = (f32x4){0.f, 0.f, 0.f, 0.f};
#pragma unroll
            for (int ks = 0; ks < 4; ++ks) { const bf16x8 af = *(LAS bf16x8*)(Bnat + (16 * st + r) * RS + (32 * ks + 8 * q) * 2); acc = mfma16(af, cf[ks], acc); }
            v2u o; o.x = pk2(acc[0], acc[1]); o.y = pk2(acc[2], acc[3]);
            *(v2u*)(CBG + (l0 + r) * 128 + 16 * st + 4 * q) = o; }
    }
    __syncthreads();
    bf16* XT = WSP(bf16, WS_XT);
    for (int rd = 0; rd < 2; ++rd) {
        {
            const int ch = tid & 255, lh = tid >> 8, hl = 4 * rd + (ch >> 6), p_ = ch & 63, head = 8 * g + hl;
            const int col = C_X + 512 * g + 256 * rd + ch, cw = 512 * g + 256 * rd + ch;
            const float w0 = F.ssm_conv_w[cw], w1 = F.ssm_conv_w[1536 + cw], w2 = F.ssm_conv_w[2 * 1536 + cw], w3 = F.ssm_conv_w[3 * 1536 + cw], bias = F.ssm_conv_b[cw];
            const bf16* p = PROJ + (size_t)(t0 + 64 * lh) * N1 + col;
            float h0 = 0.f, h1 = 0.f, h2 = 0.f;
            if (!(c == 0 && lh == 0)) { h0 = bf1(p[-3 * N1]); h1 = bf1(p[-2 * N1]); h2 = bf1(p[-1 * N1]); }
            bf16* xtg = XT + ((size_t)(bc * 16 + head) * 64 + p_) * 128;
            for (int st = 0; st < 8; ++st) {
                float raw[8], ov[8];
#pragma unroll
                for (int i = 0; i < 8; ++i) raw[i] = bf1(p[(size_t)(st * 8 + i) * N1]);
#pragma unroll
                for (int i = 0; i < 8; ++i) { const float v = w0 * h0 + w1 * h1 + w2 * h2 + w3 * raw[i] + bias; h0 = h1; h1 = h2; h2 = raw[i]; ov[i] = silu_f(v); }
                const int l = 64 * lh + 8 * st;
                v4u pk; pk.x = pk2(ov[0], ov[1]); pk.y = pk2(ov[2], ov[3]); pk.z = pk2(ov[4], ov[5]); pk.w = pk2(ov[6], ov[7]);
                *(v4u*)(xtg + l) = pk;
                const f32x4 wa = *(LAS f32x4*)(wts + hl * 128 + l), wb = *(LAS f32x4*)(wts + hl * 128 + l + 4);
                v4u pw; pw.x = pk2(ov[0] * wa.x, ov[1] * wa.y); pw.y = pk2(ov[2] * wa.z, ov[3] * wa.w); pw.z = pk2(ov[4] * wb.x, ov[5] * wb.y); pw.w = pk2(ov[6] * wb.z, ov[7] * wb.w);
                *(LAS v4u*)(xwT + ch * RS + l * 2) = pw;
            }
        }
        __syncthreads();
        {
            const int hl2 = wave >> 1, nh = wave & 1, head = 8 * g + 4 * rd + hl2;
            f32x4 acc[4][4];
#pragma unroll
            for (int a = 0; a < 4; ++a)
#pragma unroll
                for (int b2 = 0; b2 < 4; ++b2) acc[a][b2] = (f32x4){0.f, 0.f, 0.f, 0.f};
#pragma unroll
            for (int ks = 0; ks < 4; ++ks) { bf16x8 af[4], bfr[4];
#pragma unroll
                for (int nt = 0; nt < 4; ++nt) af[nt] = *(LAS bf16x8*)(BT + (64 * nh + 16 * nt + r) * RS + (32 * ks + 8 * q) * 2);
#pragma unroll
                for (int pt = 0; pt < 4; ++pt) bfr[pt] = *(LAS bf16x8*)(xwT + (64 * hl2 + 16 * pt + r) * RS + (32 * ks + 8 * q) * 2);
#pragma unroll
                for (int nt = 0; nt < 4; ++nt)
#pragma unroll
                    for (int pt = 0; pt < 4; ++pt) acc[nt][pt] = mfma16(af[nt], bfr[pt], acc[nt][pt]); }
            bf16* stg = ST + (size_t)(bc * 16 + head) * 8192;
#pragma unroll
            for (int nt = 0; nt < 4; ++nt)
#pragma unroll
                for (int pt = 0; pt < 4; ++pt) { v2u o; o.x = pk2(acc[nt][pt][0], acc[nt][pt][1]); o.y = pk2(acc[nt][pt][2], acc[nt][pt][3]);
                    *(v2u*)(stg + (16 * pt + r) * 128 + 64 * nh + 16 * nt + 4 * q) = o; }
        }
        __syncthreads();
    }
    {
        const int cg = tid & 63, rs = tid >> 6, ch0 = 512 * g + 8 * cg;
        float w0[8], w1[8], w2[8], nw[8], pm2[8], pm1[8];
#pragma unroll
        for (int e = 0; e < 8; ++e) { w0[e] = F.sc_conv_w[ch0 + e]; w1[e] = F.sc_conv_w[1024 + ch0 + e]; w2[e] = F.sc_conv_w[2048 + ch0 + e]; nw[e] = F.sc_norm_w[ch0 + e]; pm2[e] = 0.f; pm1[e] = 0.f; }
        bf16* P = WSP(bf16, WS_PROJ) + (size_t)(t0 + 16 * rs) * N1 + ch0;
        if (!(c == 0 && rs == 0)) {
            const v4u c2 = *(const v4u*)(P - 2 * N1 + C_SCC), hh2 = *(const v4u*)(P - 2 * N1 + C_SCH), c1 = *(const v4u*)(P - N1 + C_SCC), hh1 = *(const v4u*)(P - N1 + C_SCH);
            pm2[0] = bflo(c2.x) * bflo(hh2.x); pm2[1] = bfhi(c2.x) * bfhi(hh2.x); pm2[2] = bflo(c2.y) * bflo(hh2.y); pm2[3] = bfhi(c2.y) * bfhi(hh2.y);
            pm2[4] = bflo(c2.z) * bflo(hh2.z); pm2[5] = bfhi(c2.z) * bfhi(hh2.z); pm2[6] = bflo(c2.w) * bflo(hh2.w); pm2[7] = bfhi(c2.w) * bfhi(hh2.w);
            pm1[0] = bflo(c1.x) * bflo(hh1.x); pm1[1] = bfhi(c1.x) * bfhi(hh1.x); pm1[2] = bflo(c1.y) * bflo(hh1.y); pm1[3] = bfhi(c1.y) * bfhi(hh1.y);
            pm1[4] = bflo(c1.z) * bflo(hh1.z); pm1[5] = bfhi(c1.z) * bfhi(hh1.z); pm1[6] = bflo(c1.w) * bflo(hh1.w); pm1[7] = bfhi(c1.w) * bfhi(hh1.w);
        }
        for (int i = 0; i < 16; ++i) {
            bf16* row = P + (size_t)i * N1;
            const v4u bv = *(const v4u*)(row + C_SCB), cv = *(const v4u*)(row + C_SCC), hv = *(const v4u*)(row + C_SCH);
            float pr[8], bb[8], y[8];
            pr[0] = bflo(cv.x) * bflo(hv.x); pr[1] = bfhi(cv.x) * bfhi(hv.x); pr[2] = bflo(cv.y) * bflo(hv.y); pr[3] = bfhi(cv.y) * bfhi(hv.y);
            pr[4] = bflo(cv.z) * bflo(hv.z); pr[5] = bfhi(cv.z) * bfhi(hv.z); pr[6] = bflo(cv.w) * bflo(hv.w); pr[7] = bfhi(cv.w) * bfhi(hv.w);
            bb[0] = bflo(bv.x); bb[1] = bfhi(bv.x); bb[2] = bflo(bv.y); bb[3] = bfhi(bv.y); bb[4] = bflo(bv.z); bb[5] = bfhi(bv.z); bb[6] = bflo(bv.w); bb[7] = bfhi(bv.w);
            float ss = 0.f;
#pragma unroll
            for (int e = 0; e < 8; ++e) { y[e] = (w0[e] * pm2[e] + w1[e] * pm1[e] + w2[e] * pr[e]) * bb[e]; ss += y[e] * y[e]; pm2[e] = pm1[e]; pm1[e] = pr[e]; }
            ss += __shfl_xor(ss, 1); ss += __shfl_xor(ss, 2); ss += __shfl_xor(ss, 4);
            const float rstd = rsqrtf(ss * (1.0f / 64.0f) + RMS_EPS);
            v4u o; o.x = pk2(y[0] * rstd * nw[0], y[1] * rstd * nw[1]); o.y = pk2(y[2] * rstd * nw[2], y[3] * rstd * nw[3]);
            o.z = pk2(y[4] * rstd * nw[4], y[5] * rstd * nw[5]); o.w = pk2(y[6] * rstd * nw[6], y[7] * rstd * nw[7]);
            *(v4u*)(row + C_SCB) = o;
        }
    }
    __syncthreads();
}

__device__ __forceinline__ void p4_scan(Frame& F, bf16* ST) {
    const float* ACUM = WSP(const float, WS_ACUM);
    for (int e = F.bid * NT + F.tid; e < NB * 16 * 2048; e += F.G * NT) {
        const int b = e >> 15, h = (e >> 11) & 15, pn4 = e & 2047;
        bf16* base = ST + ((size_t)(b * NCH) * 16 + h) * 8192 + pn4 * 4;
        float run[4] = {0.f, 0.f, 0.f, 0.f};
        for (int c0 = 0; c0 < NCH; c0 += 8) {
            v2u s[8]; float dec[8];
#pragma unroll
            for (int k = 0; k < 8; ++k) { s[k] = *(const v2u*)(base + (size_t)(c0 + k) * 131072); dec[k] = ACUM[(size_t)(b * SEQ + (c0 + k) * LCH + 127) * 16 + h]; }
#pragma unroll
            for (int k = 0; k < 8; ++k) { const float d = __expf(dec[k]);
                v2u o; o.x = pk2(run[0], run[1]); o.y = pk2(run[2], run[3]); *(v2u*)(base + (size_t)(c0 + k) * 131072) = o;
                run[0] = run[0] * d + bflo(s[k].x); run[1] = run[1] * d + bfhi(s[k].x); run[2] = run[2] * d + bflo(s[k].y); run[3] = run[3] * d + bfhi(s[k].y); }
        }
    }
}

__device__ __forceinline__ void p5_unit(Frame& F, int unit, const bf16* ST) {
    const int g = unit & 1, bc = unit >> 1, b = bc >> 5, c = bc & 31, t0 = b * SEQ + c * LCH, tid = F.tid, lane = F.lane, wave = F.wave;
    const int r = lane & 15, q = lane >> 4, l = 16 * wave + r;
    LAS unsigned char* buf0 = F.lds; LAS unsigned char* buf1 = F.lds + 34816;
    LAS float* acum_s = (LAS float*)(F.lds + 69632);
    LAS float* dt_s = acum_s + 1024;
    const float* DT = WSP(const float, WS_DT); const float* ACUM = WSP(const float, WS_ACUM);
    const bf16* XT = WSP(const bf16, WS_XT); bf16* PROJ = WSP(bf16, WS_PROJ);
    for (int i = tid; i < 1024; i += NT) { const int hl = i >> 7, s = i & 127; acum_s[i] = ACUM[(size_t)(t0 + s) * 16 + 8 * g + hl]; dt_s[i] = DT[(size_t)(t0 + s) * 16 + 8 * g + hl]; }
    v4u cbf[4], cf[4];
    {
        const bf16* CBG = WSP(const bf16, WS_CB) + (size_t)unit * 16384; const bf16* CN = WSP(const bf16, WS_CN);
#pragma unroll
        for (int ks = 0; ks < 4; ++ks) { cbf[ks] = *(const v4u*)(CBG + l * 128 + 32 * ks + 8 * q); cf[ks] = *(const v4u*)(CN + (size_t)(t0 + l) * 256 + 128 * g + 32 * ks + 8 * q); }
    }
    v4u sx[2], sp[2];
    const int ci0 = tid, ci1 = tid + 512;
    const int lo0 = (ci0 >> 4) * RS + (ci0 & 15) * 16, lo1 = (ci1 >> 4) * RS + (ci1 & 15) * 16;
#define P5_LOAD(hd) do { const size_t o_ = (size_t)(bc * 16 + (hd)) * 8192; sx[0] = *(const v4u*)(XT + o_ + ci0 * 8); sx[1] = *(const v4u*)(XT + o_ + ci1 * 8); \
        sp[0] = *(const v4u*)(ST + o_ + ci0 * 8); sp[1] = *(const v4u*)(ST + o_ + ci1 * 8); } while (0)
#define P5_WRITE(bufp) do { *(LAS v4u*)((bufp) + lo0) = sx[0]; *(LAS v4u*)((bufp) + lo1) = sx[1]; *(LAS v4u*)((bufp) + 17408 + lo0) = sp[0]; *(LAS v4u*)((bufp) + 17408 + lo1) = sp[1]; } while (0)
    P5_LOAD(8 * g); P5_WRITE(buf0);
    __syncthreads();
    float sumsq = 0.f;
    bf16* zrow = PROJ + (size_t)(t0 + l) * N1 + C_Z + 512 * g;
#pragma unroll 1
    for (int hl = 0; hl < 8; ++hl) {
        const int head = 8 * g + hl; LAS unsigned char* cur = (hl & 1) ? buf1 : buf0; LAS unsigned char* nxtb = (hl & 1) ? buf0 : buf1;
        if (hl < 7) P5_LOAD(head + 1);
        const float acl = acum_s[hl * 128 + l];
        bf16x8 mf[4];
#pragma unroll
        for (int ks = 0; ks < 4; ++ks) { const int s0 = 32 * ks + 8 * q;
            const f32x4 a0 = *(LAS f32x4*)(acum_s + hl * 128 + s0), a1 = *(LAS f32x4*)(acum_s + hl * 128 + s0 + 4), e0 = *(LAS f32x4*)(dt_s + hl * 128 + s0), e1 = *(LAS f32x4*)(dt_s + hl * 128 + s0 + 4);
            const float as[8] = {a0.x, a0.y, a0.z, a0.w, a1.x, a1.y, a1.z, a1.w}, ds[8] = {e0.x, e0.y, e0.z, e0.w, e1.x, e1.y, e1.z, e1.w};
            const unsigned cw[4] = {cbf[ks].x, cbf[ks].y, cbf[ks].z, cbf[ks].w}; float m[8];
#pragma unroll
            for (int j = 0; j < 8; ++j) { const float cbv = (j & 1) ? bfhi(cw[j >> 1]) : bflo(cw[j >> 1]); const bool ok = (s0 + j) <= l; const float seg = ok ? (acl - as[j]) : 0.f; m[j] = ok ? cbv * __expf(seg) * ds[j] : 0.f; }
            v4u pk; pk.x = pk2(m[0], m[1]); pk.y = pk2(m[2], m[3]); pk.z = pk2(m[4], m[5]); pk.w = pk2(m[6], m[7]); mf[ks] = __builtin_bit_cast(bf16x8, pk); }
        f32x4 d1[4], d2[4];
#pragma unroll
        for (int pt = 0; pt < 4; ++pt) { d1[pt] = (f32x4){0.f, 0.f, 0.f, 0.f}; d2[pt] = (f32x4){0.f, 0.f, 0.f, 0.f}; }
#pragma unroll
        for (int ks = 0; ks < 4; ++ks) {
            if (32 * ks <= 16 * wave + 15) {
#pragma unroll
                for (int pt = 0; pt < 4; ++pt) { const bf16x8 af = *(LAS bf16x8*)(cur + (16 * pt + r) * RS + (32 * ks + 8 * q) * 2); d1[pt] = mfma16(af, mf[ks], d1[pt]); } }
#pragma unroll
            for (int pt = 0; pt < 4; ++pt) { const bf16x8 af = *(LAS bf16x8*)(cur + 17408 + (16 * pt + r) * RS + (32 * ks + 8 * q) * 2); d2[pt] = mfma16(af, __builtin_bit_cast(bf16x8, cf[ks]), d2[pt]); }
        }
        const float dfs = __expf(acl), dsk = F.d_skip[head];
#pragma unroll
        for (int pt = 0; pt < 4; ++pt) { const int p0 = 16 * pt + 4 * q;
            const v2u zv = *(const v2u*)(zrow + 64 * hl + p0); const float zf[4] = {bflo(zv.x), bfhi(zv.x), bflo(zv.y), bfhi(zv.y)}; float y[4];
#pragma unroll
            for (int e = 0; e < 4; ++e) { const float xv = bf1(*(LAS bf16*)(cur + (p0 + e) * RS + l * 2)); float v = d1[pt][e] + dfs * d2[pt][e] + dsk * xv; v *= silu_f(zf[e]); sumsq += v * v; y[e] = v; }
            v2u yo; yo.x = pk2(y[0], y[1]); yo.y = pk2(y[2], y[3]); *(v2u*)(zrow + 64 * hl + p0) = yo; }
        if (hl < 7) P5_WRITE(nxtb);
        __syncthreads();
    }
#undef P5_LOAD
#undef P5_WRITE
    sumsq += __shfl_xor(sumsq, 16); sumsq += __shfl_xor(sumsq, 32);
    const float rstd = rsqrtf(sumsq * (1.0f / 512.0f) + RMS_EPS);
    asm volatile("s_waitcnt vmcnt(0)" ::: "memory");
#pragma unroll 2
    for (int hl = 0; hl < 8; ++hl)
#pragma unroll
        for (int pt = 0; pt < 4; ++pt) { const int p0 = 16 * pt + 4 * q; const f32x4 nw = *(const f32x4*)(F.ssm_norm_w + 512 * g + 64 * hl + p0);
            const v2u yv = *(const v2u*)(zrow + 64 * hl + p0);
            v2u o; o.x = pk2(bflo(yv.x) * rstd * nw.x, bfhi(yv.x) * rstd * nw.y); o.y = pk2(bflo(yv.y) * rstd * nw.z, bfhi(yv.y) * rstd * nw.w);
            *(v2u*)(zrow + 64 * hl + p0) = o; }
    __syncthreads();
}

__device__ __forceinline__ float wave_max(float v) {
#pragma unroll
    for (int o = 1; o < 64; o <<= 1) v = fmaxf(v, __shfl_xor(v, o));
    return v;
}
__device__ __forceinline__ unsigned q4(f32x4 v, float inv, int off) {
    const int a = (int)rintf(v.x * inv) + off, b = (int)rintf(v.y * inv) + off, c = (int)rintf(v.z * inv) + off, d = (int)rintf(v.w * inv) + off;
    return (unsigned)(a & 255) | ((unsigned)(b & 255) << 8) | ((unsigned)(c & 255) << 16) | ((unsigned)(d & 255) << 24);
}
__device__ __forceinline__ void p7_ln1(Frame& F, const float* PRE) {
    const int gw = F.bid * NWAVES + F.wave, NGW = F.G * NWAVES, lane = F.lane;
    const float* COND = WSP(const float, WS_COND); float* X1 = WSP(float, WS_X1); bf16* U2 = WSP(bf16, WS_U2);
    unsigned* XQ = WSP(unsigned, WS_XQ); float* XS = WSP(float, WS_XS);
    for (int m = gw; m < T; m += NGW) {
        const int b = m >> 12; const float* cd = COND + b * 6144;
        const f32x4* xr = (const f32x4*)(PRE + (size_t)m * D) + lane;
        f32x4 v[4]; float s = 0.f;
#pragma unroll
        for (int j = 0; j < 4; ++j) { v[j] = xr[64 * j]; s += (v[j].x + v[j].y) + (v[j].z + v[j].w); }
        const float mean = wave_sum(s) * (1.f / D); float s2 = 0.f;
#pragma unroll
        for (int j = 0; j < 4; ++j) { v[j] = v[j] - mean; s2 += (v[j].x * v[j].x + v[j].y * v[j].y) + (v[j].z * v[j].z + v[j].w * v[j].w); }
        const float rstd = rsqrtf(wave_sum(s2) * (1.f / D) + LN_EPS);
        float amax = 0.f;
#pragma unroll
        for (int j = 0; j < 4; ++j) { const int col = 4 * lane + 256 * j;
            const f32x4 gg = *(const f32x4*)(F.ln1_g + col), bb = *(const f32x4*)(F.ln1_b + col), sh = *(const f32x4*)(cd + 3 * 1024 + col), scl = *(const f32x4*)(cd + 4 * 1024 + col);
            const f32x4 x1 = v[j] * rstd * gg + bb; *(f32x4*)(X1 + (size_t)m * D + col) = x1;
            const f32x4 u = x1 * (scl + 1.0f) + sh; v2u o; o.x = pk2(u.x, u.y); o.y = pk2(u.z, u.w); *(v2u*)(U2 + (size_t)m * D + col) = o;
            v[j] = u; amax = fmaxf(amax, fmaxf(fmaxf(fabsf(u.x), fabsf(u.y)), fmaxf(fabsf(u.z), fabsf(u.w)))); }
        amax = fmaxf(wave_max(amax), 1e-20f); const float inv = 127.0f / amax;
#pragma unroll
        for (int j = 0; j < 4; ++j) XQ[(size_t)m * 256 + lane + 64 * j] = q4(v[j], inv, 0);
        if (lane == 0) XS[m] = amax * (1.0f / 127.0f);
    }
    unsigned* EU = WSP(unsigned, WS_EU); unsigned* EV = WSP(unsigned, WS_EV); float* SU = WSP(float, WS_SU); float* SV = WSP(float, WS_SV);
    for (int rr = gw; rr < 2 * 16384; rr += 2 * NGW) {
        f32x4 a[2][4];
#pragma unroll
        for (int k = 0; k < 2; ++k) { const int r2 = rr + k * NGW; if (r2 < 2 * 16384) { const float* src = (r2 < 16384 ? F.expert_u : F.expert_v) + (size_t)(r2 & 16383) * D;
#pragma unroll
            for (int j = 0; j < 4; ++j) a[k][j] = *((const f32x4*)src + lane + 64 * j); } }
#pragma unroll
        for (int k = 0; k < 2; ++k) { const int r2 = rr + k * NGW; if (r2 < 2 * 16384) { const bool isv = r2 >= 16384; const int e = r2 & 16383; float amax = 0.f;
#pragma unroll
            for (int j = 0; j < 4; ++j) amax = fmaxf(amax, fmaxf(fmaxf(fabsf(a[k][j].x), fabsf(a[k][j].y)), fmaxf(fabsf(a[k][j].z), fabsf(a[k][j].w))));
            amax = fmaxf(wave_max(amax), 1e-30f); const float inv = 127.0f / amax; unsigned* dst = (isv ? EV : EU) + (size_t)e * 256;
#pragma unroll
            for (int j = 0; j < 4; ++j) dst[lane + 64 * j] = q4(a[k][j], inv, 0);
            if (lane == 0) (isv ? SV : SU)[e] = amax * (1.0f / 127.0f); } }
    }
}

__device__ __forceinline__ int med3i(int a, int b, int c) { int d; asm("v_med3_i32 %0, %1, %2, %3" : "=v"(d) : "v"(a), "v"(b), "v"(c)); return d; }
__device__ __forceinline__ int ord_key(unsigned bits) { const int s = (int)bits; return s ^ ((s >> 31) & 0x7fffffff); }
#define TOPK_INSERT(L, k) do { _Pragma("unroll") for (int j_ = 15; j_ >= 1; --j_) L[j_] = med3i(L[j_ - 1], L[j_], (k)); L[0] = max(L[0], (k)); } while (0)
__device__ __forceinline__ float gelu_exact(float v) { return 0.5f * v * (1.0f + erff(v * 0.70710678118654752f)); }

__device__ __forceinline__ void p9_topk(Frame& F, int tb) {
    const int lane = F.lane, wave = F.wave;
    LAS unsigned char* idxs = F.lds;
    const bf16* SC = WSP(const bf16, WS_SC);
    unsigned short* EIDX = WSP(unsigned short, WS_EIDX); float* GATE = WSP(float, WS_GATE);
    int L1[16], L2[16];
#pragma unroll
    for (int j = 0; j < 16; ++j) { L1[j] = (int)0x80000000; L2[j] = (int)0x80000000; }
    const bf16* s1p = SC + ((((size_t)tb * 16 + 2 * wave) * 16) * 64 + lane) * 8;
    const bf16* s2p = s1p + (size_t)16 * 64 * 8;
    for (int kc = 0; kc < 16; kc += 4) {
        v4u a[4], bq[4];
#pragma unroll
        for (int u = 0; u < 4; ++u) { a[u] = *(const v4u*)(s1p + (size_t)(kc + u) * 512); bq[u] = *(const v4u*)(s2p + (size_t)(kc + u) * 512); }
#pragma unroll
        for (int u = 0; u < 4; ++u) {
            const unsigned wa[4] = {a[u].x, a[u].y, a[u].z, a[u].w}, wb[4] = {bq[u].x, bq[u].y, bq[u].z, bq[u].w};
#pragma unroll
            for (int e = 0; e < 8; ++e) { const int idx = 8 * (kc + u) + e;
                const unsigned b1 = (e & 1) ? (wa[e >> 1] & 0xffff0000u) : (wa[e >> 1] << 16), b2 = (e & 1) ? (wb[e >> 1] & 0xffff0000u) : (wb[e >> 1] << 16);
                const int k1 = (ord_key(b1) & ~127) | (127 - idx), k2 = (ord_key(b2) & ~127) | (127 - idx);
                TOPK_INSERT(L1, k1); TOPK_INSERT(L2, k2); }
        }
    }
    float v1[16], v2[16]; unsigned ib[8];
#pragma unroll
    for (int j = 0; j < 8; ++j) ib[j] = 0u;
#pragma unroll
    for (int j = 0; j < 16; ++j) { v1[j] = __builtin_bit_cast(float, (unsigned)ord_key((unsigned)L1[j]) & 0xffff0000u); v2[j] = __builtin_bit_cast(float, (unsigned)ord_key((unsigned)L2[j]) & 0xffff0000u);
        ib[j >> 2] |= (unsigned)(127 - (L1[j] & 127)) << (8 * (j & 3)); ib[4 + (j >> 2)] |= (unsigned)(127 - (L2[j] & 127)) << (8 * (j & 3)); }
    LAS unsigned char* myidx = idxs + (wave * 64 + lane) * 32;
    { v4u o0, o1; o0.x = ib[0]; o0.y = ib[1]; o0.z = ib[2]; o0.w = ib[3]; o1.x = ib[4]; o1.y = ib[5]; o1.z = ib[6]; o1.w = ib[7]; *(LAS v4u*)myidx = o0; *(LAS v4u*)(myidx + 16) = o1; }
    int Fk[16];
#pragma unroll
    for (int j = 0; j < 16; ++j) Fk[j] = (int)0x80000000;
#pragma unroll
    for (int a = 0; a < 16; ++a)
#pragma unroll
        for (int b2 = 0; b2 < 16; ++b2)
            if ((a + 1) * (b2 + 1) <= 16) { const float sm = v1[a] + v2[b2]; const int k = (ord_key(__builtin_bit_cast(unsigned, sm)) & ~255) | (255 - (a * 16 + b2)); TOPK_INSERT(Fk, k); }
    LDS_WAIT(); asm volatile("" ::: "memory");
    float sv[16], ssum = 0.f;
#pragma unroll
    for (int j = 0; j < 16; ++j) sv[j] = __builtin_bit_cast(float, (unsigned)ord_key((unsigned)Fk[j]));
    const float smax = sv[0];
#pragma unroll
    for (int j = 0; j < 16; ++j) { sv[j] = __expf(sv[j] - smax); ssum += sv[j]; }
    const float inv = 1.0f / ssum;
    const int t = tb * 64 + lane;
    unsigned ew[8];
#pragma unroll
    for (int j = 0; j < 16; ++j) { const int ab = 255 - (Fk[j] & 255); const int i1 = myidx[ab >> 4], i2 = myidx[16 + (ab & 15)]; const unsigned e = (unsigned)(i1 * 128 + i2);
        if (j & 1) ew[j >> 1] |= e << 16; else ew[j >> 1] = e; sv[j] *= inv; }
    { v4u o0, o1; o0.x = ew[0]; o0.y = ew[1]; o0.z = ew[2]; o0.w = ew[3]; o1.x = ew[4]; o1.y = ew[5]; o1.z = ew[6]; o1.w = ew[7];
      *(v4u*)(EIDX + (size_t)t * 128 + wave * 16) = o0; *(v4u*)(EIDX + (size_t)t * 128 + wave * 16 + 8) = o1; }
#pragma unroll
    for (int j4 = 0; j4 < 4; ++j4) *(f32x4*)(GATE + (size_t)t * 128 + wave * 16 + 4 * j4) = (f32x4){sv[4 * j4], sv[4 * j4 + 1], sv[4 * j4 + 2], sv[4 * j4 + 3]};
    LDS_WAIT(); __syncthreads();
}

__device__ __forceinline__ int dot4(unsigned a, unsigned b, int c) { return __builtin_amdgcn_sdot4((int)a, (int)b, c, false); }
__device__ __forceinline__ void p10_u(Frame& F) {
    const int lane = F.lane, wave = F.wave, q = lane >> 4, j16 = lane & 15;
    LAS unsigned* plist = (LAS unsigned*)(F.lds + wave * 1024);
    const unsigned char* XQ = WSP(const unsigned char, WS_XQ); const unsigned char* EU = WSP(const unsigned char, WS_EU);
    const float* XS = WSP(const float, WS_XS); const float* SU = WSP(const float, WS_SU); const float* SV = WSP(const float, WS_SV);
    const unsigned* EIDX2 = WSP(const unsigned, WS_EIDX); const float* GATE = WSP(const float, WS_GATE); float* ACTW = WSP(float, WS_ACT);
    const int xg = F.bid & 7, rk = F.bid >> 3, nrk = (F.G - xg + 7) / 8, tstep = nrk * NWAVES;
    const unsigned slice = (unsigned)xg;
    const unsigned long long below = (1ull << lane) - 1ull;
    unsigned ee[2] = {0u, 0u};
#pragma unroll
    for (int s2 = 0; s2 < 2; ++s2) { const int tt = rk * NWAVES + wave + s2 * tstep; if (tt < T) ee[s2] = EIDX2[(size_t)tt * 64 + lane]; }
    for (int t = rk * NWAVES + wave; t < T; t += 2 * tstep) {
        int cnt[2]; v4u xc[2][4]; float xs[2];
#pragma unroll
        for (int s2 = 0; s2 < 2; ++s2) { const int tt = t + s2 * tstep; cnt[s2] = 0; xs[s2] = 0.f;
            if (tt < T) {
                const unsigned e0 = ee[s2] & 0xffffu, e1 = ee[s2] >> 16;
                const bool f0 = (e0 >> 11) == slice, f1 = (e1 >> 11) == slice;
                const unsigned long long m0 = __ballot(f0), m1 = __ballot(f1);
                const int n0 = __popcll(m0); cnt[s2] = n0 + __popcll(m1);
                if (f0) plist[s2 * 128 + __popcll(m0 & below)] = (unsigned)(2 * lane) | (e0 << 16);
                if (f1) plist[s2 * 128 + n0 + __popcll(m1 & below)] = (unsigned)(2 * lane + 1) | (e1 << 16);
                xs[s2] = XS[tt];
#pragma unroll
                for (int i = 0; i < 4; ++i) xc[s2][i] = *(const v4u*)(XQ + (size_t)tt * D + 256 * i + 16 * j16);
                const int tn = tt + 2 * tstep; if (tn < T) ee[s2] = EIDX2[(size_t)tn * 64 + lane];
            } }
        LDS_WAIT(); asm volatile("" ::: "memory");
        const int maxc = cnt[0] > cnt[1] ? cnt[0] : cnt[1];
        for (int pi = 0; pi < maxc; pi += 16) {
            unsigned pp[2][4]; bool ok[2][4]; v4u w[2][4][4]; float su[2][4], gt[2][4], sv[2][4];
#pragma unroll
            for (int s2 = 0; s2 < 2; ++s2)
#pragma unroll
                for (int k = 0; k < 4; ++k) { const int ix = pi + 4 * k + q; ok[s2][k] = ix < cnt[s2]; pp[s2][k] = plist[s2 * 128 + (ok[s2][k] ? ix : 0)];
                    const unsigned e = pp[s2][k] >> 16; const unsigned char* rp = EU + (size_t)e * D + 16 * j16;
                    su[s2][k] = 0.f; gt[s2][k] = 0.f; sv[s2][k] = 0.f;
#pragma unroll
                    for (int i = 0; i < 4; ++i) w[s2][k][i] = (v4u){0u, 0u, 0u, 0u};
                    if (ok[s2][k]) {
#pragma unroll
                        for (int i = 0; i < 4; ++i) w[s2][k][i] = *(const v4u*)(rp + 256 * i);
                        su[s2][k] = SU[e]; sv[s2][k] = SV[e]; gt[s2][k] = GATE[(size_t)(t + s2 * tstep) * 128 + (pp[s2][k] & 0xffffu)]; } }
#pragma unroll
            for (int s2 = 0; s2 < 2; ++s2)
#pragma unroll
                for (int k = 0; k < 4; ++k) { int a = 0, bq = 0;
#pragma unroll
                    for (int i = 0; i < 4; ++i) { a = dot4(w[s2][k][i].x, xc[s2][i].x, a); bq = dot4(w[s2][k][i].y, xc[s2][i].y, bq); a = dot4(w[s2][k][i].z, xc[s2][i].z, a); bq = dot4(w[s2][k][i].w, xc[s2][i].w, bq); }
                    int hs = a + bq;
#pragma unroll
                    for (int o = 1; o < 16; o <<= 1) hs += __shfl_xor(hs, o);
                    if (j16 == 0 && ok[s2][k]) { const float h = (float)hs * (su[s2][k] * xs[s2]);
                        ACTW[(size_t)(t + s2 * tstep) * 128 + (pp[s2][k] & 0xffffu)] = gelu_exact(h) * gt[s2][k] * sv[s2][k]; } }
        }
        LDS_WAIT(); asm volatile("" ::: "memory");
    }
}

__device__ __forceinline__ void p11_v(Frame& F) {
    const int lane = F.lane, wave = F.wave, g8 = lane >> 3, c8 = lane & 7;
    LAS unsigned char* wl = F.lds + wave * 1024;
    const unsigned char* EV = WSP(const unsigned char, WS_EV);
    const unsigned* EIDX2 = WSP(const unsigned, WS_EIDX); const float* ACT = WSP(const float, WS_ACT); bf16* FFN = WSP(bf16, WS_FFN);
    const int xg = F.bid & 7, rk = F.bid >> 3, nrk = (F.G - xg + 7) / 8, tstep = nrk * NWAVES;
    const int slice = xg;
    const unsigned char* evs = EV + 128 * slice + 16 * c8;
    unsigned ee[2] = {0u, 0u}; v2u aa[2] = {(v2u){0u, 0u}, (v2u){0u, 0u}};
#pragma unroll
    for (int s2 = 0; s2 < 2; ++s2) { const int tt = rk * NWAVES + wave + s2 * tstep; if (tt < T) { ee[s2] = EIDX2[(size_t)tt * 64 + lane]; aa[s2] = *(const v2u*)(ACT + (size_t)tt * 128 + 2 * lane); } }
    for (int t = rk * NWAVES + wave; t < T; t += 2 * tstep) {
        float ascale[2]; v4u vv[2][4][4]; unsigned aq[2][4];
#pragma unroll
        for (int s2 = 0; s2 < 2; ++s2) { const int tt = t + s2 * tstep;
            const unsigned ax_ = aa[s2].x, ay_ = aa[s2].y; const float a0 = __uint_as_float(ax_), a1 = __uint_as_float(ay_);
            const float amax = fmaxf(wave_max(fmaxf(fabsf(a0), fabsf(a1))), 1e-30f), inv = 127.0f / amax; ascale[s2] = amax * (1.0f / 127.0f);
            const int q0 = (int)rintf(a0 * inv), q1 = (int)rintf(a1 * inv);
            *(LAS unsigned*)(wl + s2 * 512 + 4 * lane) = ee[s2];
            *(LAS unsigned short*)(wl + s2 * 512 + 256 + 2 * lane) = (unsigned short)((q0 & 255) | ((q1 & 255) << 8));
            const int tn = tt + 2 * tstep; if (tn < T) { ee[s2] = EIDX2[(size_t)tn * 64 + lane]; aa[s2] = *(const v2u*)(ACT + (size_t)tn * 128 + 2 * lane); } }
        LDS_WAIT(); asm volatile("" ::: "memory");
#pragma unroll
        for (int s2 = 0; s2 < 2; ++s2) { const bool valid = (t + s2 * tstep) < T;
#pragma unroll
            for (int k = 0; k < 4; ++k) { const v2u ev = *(LAS v2u*)(wl + s2 * 512 + 2 * (16 * g8 + 4 * k)); aq[s2][k] = *(LAS unsigned*)(wl + s2 * 512 + 256 + 4 * (4 * g8 + k));
                const unsigned e4[4] = {ev.x & 0xffffu, ev.x >> 16, ev.y & 0xffffu, ev.y >> 16};
#pragma unroll
                for (int j = 0; j < 4; ++j) vv[s2][k][j] = valid ? *(const v4u*)(evs + (size_t)e4[j] * D) : (v4u){0u, 0u, 0u, 0u}; } }
#pragma unroll
        for (int s2 = 0; s2 < 2; ++s2) { const int tt = t + s2 * tstep;
            int acc[16];
#pragma unroll
            for (int k = 0; k < 16; ++k) acc[k] = 0;
#pragma unroll
            for (int k = 0; k < 4; ++k) {
#pragma unroll
                for (int d = 0; d < 4; ++d) { const unsigned r0 = vv[s2][k][0][d], r1 = vv[s2][k][1][d], r2 = vv[s2][k][2][d], r3 = vv[s2][k][3][d];
                    const unsigned lo01 = __builtin_amdgcn_perm(r1, r0, 0x05010400u), hi01 = __builtin_amdgcn_perm(r1, r0, 0x07030602u);
                    const unsigned lo23 = __builtin_amdgcn_perm(r3, r2, 0x05010400u), hi23 = __builtin_amdgcn_perm(r3, r2, 0x07030602u);
                    const unsigned t0 = __builtin_amdgcn_perm(lo23, lo01, 0x05040100u), t1 = __builtin_amdgcn_perm(lo23, lo01, 0x07060302u);
                    const unsigned t2 = __builtin_amdgcn_perm(hi23, hi01, 0x05040100u), t3 = __builtin_amdgcn_perm(hi23, hi01, 0x07060302u);
                    acc[4 * d + 0] = dot4(t0, aq[s2][k], acc[4 * d + 0]); acc[4 * d + 1] = dot4(t1, aq[s2][k], acc[4 * d + 1]);
                    acc[4 * d + 2] = dot4(t2, aq[s2][k], acc[4 * d + 2]); acc[4 * d + 3] = dot4(t3, aq[s2][k], acc[4 * d + 3]); } }
            float fo[16];
#pragma unroll
            for (int k = 0; k < 16; ++k) { int v = acc[k]; v += __shfl_xor(v, 8); v += __shfl_xor(v, 16); v += __shfl_xor(v, 32); fo[k] = (float)v * ascale[s2]; }
            if (g8 == 0 && tt < T) { v4u o0, o1; o0.x = pk2(fo[0], fo[1]); o0.y = pk2(fo[2], fo[3]); o0.z = pk2(fo[4], fo[5]); o0.w = pk2(fo[6], fo[7]);
                o1.x = pk2(fo[8], fo[9]); o1.y = pk2(fo[10], fo[11]); o1.z = pk2(fo[12], fo[13]); o1.w = pk2(fo[14], fo[15]);
                bf16* fp = FFN + (size_t)tt * D + 128 * slice + 16 * c8; *(v4u*)fp = o0; *(v4u*)(fp + 8) = o1; } }
        LDS_WAIT(); asm volatile("" ::: "memory");
    }
}

__device__ __forceinline__ void p12_ln2(Frame& F) {
    const int gw = F.bid * NWAVES + F.wave, NGW = F.G * NWAVES, lane = F.lane;
    const float* COND = WSP(const float, WS_COND); const float* X1 = WSP(const float, WS_X1); const bf16* FFN = WSP(const bf16, WS_FFN);
    for (int t = gw; t < T; t += NGW) {
        const int b = t >> 12;
        const float* x1p = X1 + (size_t)t * D + 8 * lane; const float* g2 = COND + b * 6144 + 5 * 1024 + 8 * lane; const bf16* fp = FFN + (size_t)t * D + 8 * lane;
        float rv[16]; float s = 0.f;
#pragma unroll
        for (int hf = 0; hf < 2; ++hf) { const v4u fv = *(const v4u*)(fp + 512 * hf); const float ff[8] = {bflo(fv.x), bfhi(fv.x), bflo(fv.y), bfhi(fv.y), bflo(fv.z), bfhi(fv.z), bflo(fv.w), bfhi(fv.w)};
#pragma unroll
            for (int k4 = 0; k4 < 2; ++k4) { const f32x4 xv = *(const f32x4*)(x1p + 512 * hf + 4 * k4), gv = *(const f32x4*)(g2 + 512 * hf + 4 * k4);
#pragma unroll
                for (int e = 0; e < 4; ++e) { const float v = ALPHA * xv[e] + (1.0f + gv[e]) * ff[4 * k4 + e]; rv[8 * hf + 4 * k4 + e] = v; s += v; } } }
        const float mean = wave_sum(s) * (1.f / D); float s2 = 0.f;
#pragma unroll
        for (int k = 0; k < 16; ++k) { rv[k] -= mean; s2 += rv[k] * rv[k]; }
        const float rstd = rsqrtf(wave_sum(s2) * (1.f / D) + LN_EPS);
        float* op = F.out + (size_t)t * D + 8 * lane;
#pragma unroll
        for (int hf = 0; hf < 2; ++hf)
#pragma unroll
            for (int k4 = 0; k4 < 2; ++k4) { const f32x4 gg = *(const f32x4*)(F.ln2_g + 8 * lane + 512 * hf + 4 * k4), bb = *(const f32x4*)(F.ln2_b + 8 * lane + 512 * hf + 4 * k4); f32x4 o;
#pragma unroll
                for (int e = 0; e < 4; ++e) o[e] = rv[8 * hf + 4 * k4 + e] * rstd * gg[e] + bb[e];
                *(f32x4*)(op + 512 * hf + 4 * k4) = o; }
    }
}

constexpr int N_PHASES = 13;
struct Args { const float* in[23]; float* out; unsigned char* ws; int ph_lo, ph_hi; };
__global__ void __launch_bounds__(NT, 2) fwd_kernel(Args args) {
    extern __shared__ __attribute__((aligned(16))) unsigned char lds[];
    Frame F;
    F.lds = (LAS unsigned char*)lds;
    F.tid = threadIdx.x; F.lane = F.tid & 63; F.wave = __builtin_amdgcn_readfirstlane(F.tid >> 6);
    F.G = gridDim.x; F.bid = blockIdx.x;
    F.x = args.in[0]; F.c = args.in[1]; F.w_cond = args.in[2]; F.b_cond = args.in[3]; F.w_in = args.in[4]; F.sc_conv_w = args.in[5]; F.ssm_conv_w = args.in[6]; F.ssm_conv_b = args.in[7];
    F.dt_bias = args.in[8]; F.a_log = args.in[9]; F.d_skip = args.in[10]; F.sc_norm_w = args.in[11]; F.ssm_norm_w = args.in[12]; F.w_out = args.in[13]; F.ln1_g = args.in[14]; F.ln1_b = args.in[15];
    F.w_query = args.in[16]; F.sub_keys1 = args.in[17]; F.sub_keys2 = args.in[18]; F.expert_u = args.in[19]; F.expert_v = args.in[20]; F.ln2_g = args.in[21]; F.ln2_b = args.in[22];
    F.out = args.out; F.ws = args.ws;
    volatile LAS unsigned* MISC = (volatile LAS unsigned*)(F.lds + LDS_MISC);
    if (F.tid < 16) MISC[F.tid] = 0u;
    __syncthreads();
    const int lo = args.ph_lo, hi = args.ph_hi;
    XcdBarrier bar; bar.bar = (unsigned*)(F.ws + WS_CTL); bar.x = 0; bar.st = nullptr;
    if (hi - lo > 1) bar = xcd_barrier_post((unsigned*)(F.ws + WS_CTL), MISC + 8);
#ifndef PH_MASK
#define PH_MASK 0x1fff
#endif
#define IN(k) ((((PH_MASK) >> (k)) & 1) && lo <= (k) && (k) < hi)
#define SEAM(k) do { if (IN(k) && IN((k) + 1)) xcd_barrier(bar); } while (0)
    bf16* U1 = (bf16*)F.out; bf16* ST = (bf16*)F.out; float* PRE = F.out;
#ifndef REP_MASK
#define REP_MASK 0
#endif
#define REPB(k) (((REP_MASK) >> (k)) & 1)
#define B0 p0_prologue(F)
#define B1 p1_modulate(F, U1)
#define B2 do { pg8::Gemm g{U1, WSP(bf16, WS_WIN), T, N1, D, D, D, 1 << 30, 0}; pg8::StaticOrder S; S.init(T, N1, F.G, F.bid); \
        pg8::EpiBf16 E{WSP(bf16, WS_PROJ), N1}; pg8::gemm_phase<pg8::EpiBf16, pg8::StaticOrder>(F.lds, g, S, E); } while (0)
#define B6 do { pg8::Gemm g{WSP(bf16, WS_PROJ), WSP(bf16, WS_WOUT), T, D, 2048, N1, 2048, 16, (C_Z - 1024) * 2}; pg8::StaticOrder S; S.init(T, D, F.G, F.bid); \
        pg8::EpiPre E{F.x, WSP(float, WS_COND) + 2 * 1024, PRE, ALPHA}; pg8::gemm_phase<pg8::EpiPre, pg8::StaticOrder>(F.lds, g, S, E); } while (0)
#define B7 p7_ln1(F, PRE)
#define B8 do { pg8::Gemm g{WSP(bf16, WS_U2), WSP(bf16, WS_WQ), T, 2048, D, D, D, 1 << 30, 0}; pg8::StaticOrder S; S.init(T, 2048, F.G, F.bid); \
        pg8::EpiScores E{WSP(bf16, WS_SC)}; pg8::gemm_phase<pg8::EpiScores, pg8::StaticOrder>(F.lds, g, S, E); } while (0)
#define B9 do { for (int tb = F.bid; tb < T / 64; tb += F.G) p9_topk(F, tb); } while (0)
#define B10 p10_u(F)
#define B11 p11_v(F)
#define B12 p12_ln2(F)
#define RUN(k, body) do { if (IN(k)) { body; if (REPB(k)) { xcd_barrier(bar); body; } } } while (0)
    RUN(0, B0); SEAM(0);
    RUN(1, B1); SEAM(1);
    RUN(2, B2); SEAM(2);
    if (IN(3)) { for (int u = F.bid; u < NB * NCH * 2; u += F.G) p3_unit(F, u, ST); } SEAM(3);
    if (IN(4)) { p4_scan(F, ST); } SEAM(4);
    if (IN(5)) { for (int u = F.bid; u < NB * NCH * 2; u += F.G) p5_unit(F, u, ST); } SEAM(5);
    RUN(6, B6); SEAM(6);
    RUN(7, B7); SEAM(7);
    RUN(8, B8); SEAM(8);
    RUN(9, B9); SEAM(9);
    RUN(10, B10); SEAM(10);
    RUN(11, B11); SEAM(11);
    RUN(12, B12);
#undef IN
#undef SEAM
}

extern "C" void kernel_launch(void* const* d_in, const int* in_sizes, int n_in, void* d_out, int out_size, void* d_ws, size_t ws_size, hipStream_t stream) {
    static int grid = 0;
    if (grid == 0) {
        if (n_in != 23 || out_size != T * D || ws_size < WS_END) { fprintf(stderr, "kernel_launch: unexpected shapes: n_in %d out %d ws %zu\n", n_in, out_size, ws_size); grid = -1; return; }
        int dev = 0, cus = 0, per_cu = 0;
        if (hipGetDevice(&dev) != hipSuccess || hipDeviceGetAttribute(&cus, hipDeviceAttributeMultiprocessorCount, dev) != hipSuccess) { grid = -1; return; }
        if (hipFuncSetAttribute((const void*)fwd_kernel, hipFuncAttributeMaxDynamicSharedMemorySize, LDS_BYTES) != hipSuccess) { fprintf(stderr, "kernel_launch: hipFuncSetAttribute failed\n"); grid = -1; return; }
        if (hipOccupancyMaxActiveBlocksPerMultiprocessor(&per_cu, (const void*)fwd_kernel, NT, LDS_BYTES) != hipSuccess || per_cu < 1) { fprintf(stderr, "kernel_launch: occupancy query says %d\n", per_cu); (void)hipGetLastError(); grid = -1; return; }
        grid = cus;
    }
    if (grid < 0) return;
    (void)hipMemsetAsync((char*)d_ws + WS_CTL, 0, CTL_ZERO_BYTES, stream);
    Args a{};
    for (int i = 0; i < 23; ++i) a.in[i] = (const float*)d_in[i];
    a.out = (float*)d_out; a.ws = (unsigned char*)d_ws;
#if MK_N_LAUNCHES == 1
    a.ph_lo = 0; a.ph_hi = N_PHASES;
    hipLaunchKernelGGL(fwd_kernel, dim3(grid), dim3(NT), LDS_BYTES, stream, a);
#else
    for (int p = 0; p < N_PHASES; ++p) { a.ph_lo = p; a.ph_hi = p + 1; hipLaunchKernelGGL(fwd_kernel, dim3(grid), dim3(NT), LDS_BYTES, stream, a); }
#endif
}
```
